# Optimizing an MI355X kernel written in HIP

```python
import jax
import jax.numpy as jnp
from jax import lax
import numpy as np

D_MODEL = 1024
BATCH = 2
SEQ = 16384
DEPTH = 2

HEAD_DIM = 64
ATTN_BLOCK = 128
DIL_PATTERNS = ((128, 1), (512, 4), (2048, 16))
N_DIL = 3
DIL_HEADS = 6
CONV_WIDTH = 384
CONV_K = 3
NSA_Q_HEADS = 6
NSA_KV_HEADS = 2
NSA_GROUP = NSA_Q_HEADS // NSA_KV_HEADS
CMP_BLOCK = 32
CMP_STRIDE = 16
CMP_HIDDEN = 128
SEL_BLOCK = 64
N_SEL = 16
NSA_WINDOW = 512
N_NSA_BRANCH = 3
SWA_Q_HEADS = 6
SWA_KV_HEADS = 2
SWA_GROUP = SWA_Q_HEADS // SWA_KV_HEADS
SWA_WINDOW = 128
BRANCH_WIDTH = 384
N_BRANCH = 4
D_FF = 2816
N_EXPERTS = 8
TOP_K = 2
D_FF_EXPERT = 3584
PLE_DIM = 256
LN_EPS = 1e-5
ALPHA = (2 * DEPTH) ** 0.25
BETA = (8 * DEPTH) ** -0.25
NEG_INF = -1e30
DIL_WIDTH = N_DIL * DIL_HEADS * HEAD_DIM
NSA_KV_WIDTH = NSA_KV_HEADS * HEAD_DIM
SWA_KV_WIDTH = SWA_KV_HEADS * HEAD_DIM
COLUMN_SIZES = (DIL_WIDTH, DIL_WIDTH, DIL_WIDTH,
                CONV_WIDTH, CONV_WIDTH, CONV_WIDTH,
                NSA_Q_HEADS * HEAD_DIM,
                NSA_KV_WIDTH, NSA_KV_WIDTH, NSA_KV_WIDTH, NSA_KV_WIDTH, NSA_KV_WIDTH, NSA_KV_WIDTH,
                N_NSA_BRANCH * NSA_Q_HEADS,
                SWA_Q_HEADS * HEAD_DIM, SWA_KV_WIDTH, SWA_KV_WIDTH)
N_IN = sum(COLUMN_SIZES)

kernel_name = 'hybrid_dilated_conv_nsa_swa_moe_deepnorm'


def layer_norm(x, g, b):
    xf = x.astype(jnp.float32)
    mu = jnp.mean(xf, axis=-1, keepdims=True)
    var = jnp.mean(jnp.square(xf - mu), axis=-1, keepdims=True)
    return ((xf - mu) * lax.rsqrt(var + LN_EPS) * g + b).astype(x.dtype)


def banded_attention(q, k, v, window):
    b, L, kv, g, hd = q.shape
    nb = -(-L // ATTN_BLOCK)
    lp = nb * ATTN_BLOCK
    n_prev = -(-window // ATTN_BLOCK)
    span = (n_prev + 1) * ATTN_BLOCK
    qb = jnp.pad(q, ((0, 0), (0, lp - L), (0, 0), (0, 0), (0, 0))).reshape(b, nb, ATTN_BLOCK, kv, g, hd)

    def key_windows(t):
        t = jnp.pad(t, ((0, 0), (n_prev * ATTN_BLOCK, lp - L), (0, 0), (0, 0)))
        t = t.reshape(b, nb + n_prev, ATTN_BLOCK, kv, hd)
        return jnp.concatenate([t[:, s:s + nb] for s in range(n_prev + 1)], axis=2)

    kw = key_windows(k)
    vw = key_windows(v)
    s = jnp.einsum('bnqkgd,bnjkd->bnkgqj', qb, kw, preferred_element_type=jnp.float32) * (hd ** -0.5)
    qi = jnp.arange(ATTN_BLOCK)[:, None]
    kj = jnp.arange(span)[None, :]
    dist = n_prev * ATTN_BLOCK + qi - kj
    kpos = (jnp.arange(nb)[:, None, None] - n_prev) * ATTN_BLOCK + kj[None]
    mask = (dist >= 0) & (dist <= window) & (kpos >= 0)
    s = jnp.where(mask[None, :, None, None], s, NEG_INF)
    m = jnp.max(s, axis=-1, keepdims=True)
    e = jnp.exp(s - m)
    l = jnp.sum(e, axis=-1, keepdims=True)
    o = jnp.einsum('bnkgqj,bnjkd->bnqkgd', e / l, vw.astype(jnp.float32))
    lse = (m + jnp.log(l))[..., 0].transpose(0, 1, 4, 2, 3)
    return o.reshape(b, lp, kv, g, hd)[:, :L], lse.reshape(b, lp, kv, g)[:, :L]


def dilated_attention(q, k, v):
    b, S = q.shape[:2]
    outs = []
    lses = []
    for g, (window, dil) in enumerate(DIL_PATTERNS):
        def by_stride(t):
            t = t[:, :, g].reshape(b, S // dil, dil, DIL_HEADS, HEAD_DIM).transpose(0, 2, 1, 3, 4)
            return t.reshape(b * dil, S // dil, DIL_HEADS, HEAD_DIM)
        o, lse = banded_attention(by_stride(q)[:, :, :, None], by_stride(k), by_stride(v), window // dil)
        o = o.reshape(b, dil, S // dil, DIL_HEADS, HEAD_DIM).transpose(0, 2, 1, 3, 4)
        lse = lse.reshape(b, dil, S // dil, DIL_HEADS).transpose(0, 2, 1, 3)
        outs.append(o.reshape(b, S, DIL_HEADS, HEAD_DIM))
        lses.append(lse.reshape(b, S, DIL_HEADS))
    wts = jax.nn.softmax(jnp.stack(lses), axis=0)
    return jnp.sum(wts[..., None] * jnp.stack(outs), axis=0)


def gated_short_conv(gate_b, gate_c, h, conv_w):
    u = gate_c * h
    y = lax.conv_general_dilated(u, conv_w[:, None, :].astype(u.dtype), window_strides=(1,),
                                 padding=((CONV_K - 1, 0),), dimension_numbers=('NWC', 'WIO', 'NWC'),
                                 feature_group_count=u.shape[-1])
    return gate_b * y


def compress_blocks(t, pos, w1, b1, w2, b2):
    b, S, kv, hd = t.shape
    r = CMP_BLOCK // CMP_STRIDE
    nc = S // CMP_STRIDE - r + 1
    chunks = t.reshape(b, S // CMP_STRIDE, CMP_STRIDE, kv, hd)
    blocks = jnp.concatenate([chunks[:, i:i + nc] for i in range(r)], axis=2) + pos[None, None, :, None, :]
    flat = blocks.transpose(0, 1, 3, 2, 4).reshape(b, nc, kv, CMP_BLOCK * hd)
    return jax.nn.gelu(flat @ w1 + b1) @ w2 + b2


def native_sparse_attention(q, k_cmp, v_cmp, k_slc, v_slc, k_win, v_win, gates,
                            cmp_pos, cmp_w1, cmp_b1, cmp_w2, cmp_b2):
    b, S = q.shape[:2]
    kc = compress_blocks(k_cmp, cmp_pos[0], cmp_w1[0], cmp_b1[0], cmp_w2[0], cmp_b2[0])
    vc = compress_blocks(v_cmp, cmp_pos[1], cmp_w1[1], cmp_b1[1], cmp_w2[1], cmp_b2[1])
    nc = kc.shape[1]
    ns = S // SEL_BLOCK
    n_sel = min(N_SEL, ns)
    ksb = k_slc.reshape(b, ns, SEL_BLOCK, NSA_KV_HEADS, HEAD_DIM).transpose(0, 3, 1, 2, 4)
    vsb = v_slc.reshape(b, ns, SEL_BLOCK, NSA_KV_HEADS, HEAD_DIM).transpose(0, 3, 1, 2, 4)
    c_start = jnp.arange(nc) * CMP_STRIDE
    c_end = c_start + CMP_BLOCK - 1
    s_start = jnp.arange(ns) * SEL_BLOCK
    overlap = ((c_start[:, None] < s_start[None, :] + SEL_BLOCK)
               & (c_end[:, None] >= s_start[None, :])).astype(jnp.float32)
    sel_ids = jnp.arange(ns)
    scale = HEAD_DIM ** -0.5
    gather = jax.vmap(jax.vmap(lambda blocks, ix: blocks[ix]))

    def query_block(args):
        qb, i = args
        t = i * ATTN_BLOCK + jnp.arange(ATTN_BLOCK)
        s = jnp.einsum('bqkgd,bckd->bkgqc', qb, kc, preferred_element_type=jnp.float32) * scale
        vis = c_end[None, :] <= t[:, None]
        s = jnp.where(vis, s, NEG_INF)
        e = jnp.exp(s - jnp.max(s, axis=-1, keepdims=True)) * vis
        p_cmp = e / jnp.maximum(jnp.sum(e, axis=-1, keepdims=True), 1e-30)
        o_cmp = jnp.einsum('bkgqc,bckd->bqkgd', p_cmp, vc.astype(jnp.float32))
        imp = jnp.einsum('bkgqc,cj->bkqj', p_cmp, overlap)
        cur = t // SEL_BLOCK
        causal = sel_ids[None, :] <= cur[:, None]
        forced = (sel_ids[None, :] == 0) | (sel_ids[None, :] == cur[:, None]) | (sel_ids[None, :] == cur[:, None] - 1)
        imp = jnp.where(forced, jnp.inf, jnp.where(causal, imp, -jnp.inf))
        top, idx = lax.top_k(imp, n_sel)
        valid = top > -jnp.inf
        kg = gather(ksb, idx)
        vg = gather(vsb, idx)
        s2 = jnp.einsum('bqkgd,bkqnjd->bkgqnj', qb, kg, preferred_element_type=jnp.float32) * scale
        kpos = idx[..., None] * SEL_BLOCK + jnp.arange(SEL_BLOCK)
        m2 = valid[..., None] & (kpos <= t[None, None, :, None, None])
        s2 = jnp.where(m2[:, :, None], s2, NEG_INF)
        sh = s2.shape
        p2 = jax.nn.softmax(s2.reshape(sh[:4] + (n_sel * SEL_BLOCK,)), axis=-1).reshape(sh)
        o_slc = jnp.einsum('bkgqnj,bkqnjd->bqkgd', p2, vg.astype(jnp.float32))
        return o_cmp, o_slc

    nq = S // ATTN_BLOCK
    qblk = q.reshape(b, nq, ATTN_BLOCK, NSA_KV_HEADS, NSA_GROUP, HEAD_DIM).transpose(1, 0, 2, 3, 4, 5)
    o_cmp, o_slc = lax.map(query_block, (qblk, jnp.arange(nq)))

    def unblock(o):
        return o.transpose(1, 0, 2, 3, 4, 5).reshape(b, S, NSA_KV_HEADS, NSA_GROUP, HEAD_DIM)

    o_win, _ = banded_attention(q, k_win, v_win, NSA_WINDOW - 1)
    return (gates[:, :, 0][..., None] * unblock(o_cmp)
            + gates[:, :, 1][..., None] * unblock(o_slc)
            + gates[:, :, 2][..., None] * o_win)


def token_mixers(x, w_in, conv_w, cmp_pos, cmp_w1, cmp_b1, cmp_w2, cmp_b2, sinks):
    b, S, _ = x.shape
    z = x @ w_in
    (qa, ka, va, gb, gc, hb, qc, kcc, vcc, ksc, vsc, kwc, vwc, gn, qd, kd, vd) = jnp.split(
        z, np.cumsum(COLUMN_SIZES)[:-1].tolist(), axis=-1)

    def dil(t):
        return t.reshape(b, S, N_DIL, DIL_HEADS, HEAD_DIM)

    def nkv(t):
        return t.reshape(b, S, NSA_KV_HEADS, HEAD_DIM)

    def skv(t):
        return t.reshape(b, S, SWA_KV_HEADS, HEAD_DIM)

    o_a = dilated_attention(dil(qa), dil(ka), dil(va)).reshape(b, S, BRANCH_WIDTH)
    o_b = gated_short_conv(gb, gc, hb, conv_w)
    nsa_gates = jax.nn.sigmoid(gn.astype(jnp.float32)).reshape(b, S, N_NSA_BRANCH, NSA_KV_HEADS, NSA_GROUP)
    o_c = native_sparse_attention(qc.reshape(b, S, NSA_KV_HEADS, NSA_GROUP, HEAD_DIM),
                                  nkv(kcc), nkv(vcc), nkv(ksc), nkv(vsc), nkv(kwc), nkv(vwc), nsa_gates,
                                  cmp_pos, cmp_w1, cmp_b1, cmp_w2, cmp_b2).reshape(b, S, BRANCH_WIDTH)
    o_d, lse_d = banded_attention(qd.reshape(b, S, SWA_KV_HEADS, SWA_GROUP, HEAD_DIM), skv(kd), skv(vd),
                                  SWA_WINDOW - 1)
    sink_keep = jax.nn.sigmoid(lse_d - sinks.reshape(SWA_KV_HEADS, SWA_GROUP).astype(jnp.float32))
    o_d = (o_d * sink_keep[..., None]).reshape(b, S, BRANCH_WIDTH)
    return [o_a.astype(x.dtype), o_b.astype(x.dtype), o_c.astype(x.dtype), o_d.astype(x.dtype)]


def swiglu(h, w_gate, w_up, w_down):
    return (jax.nn.silu(h @ w_gate) * (h @ w_up)) @ w_down


def moe_swiglu(h, w_router, b_router, w_gate, w_up, w_down):
    logits = (h @ w_router + b_router).astype(jnp.float32)
    top_v, top_i = lax.top_k(logits, TOP_K)
    top_w = jax.nn.softmax(top_v, axis=-1)
    comb = jnp.sum(jax.nn.one_hot(top_i, N_EXPERTS, dtype=jnp.float32) * top_w[..., None], axis=-2)
    comb = comb.astype(h.dtype)
    out = jnp.zeros_like(h)
    for e in range(N_EXPERTS):
        out = out + comb[..., e:e + 1] * swiglu(h, w_gate[e], w_up[e], w_down[e])
    return out


def setup_inputs(seed: int = 0) -> dict:
    key = jax.random.key(seed)
    ks = jax.random.split(key, 32)
    d = D_MODEL
    n_dense = (DEPTH + 1) // 2
    n_moe = DEPTH // 2

    def nrm(k, shape, scale):
        return jax.random.normal(k, shape, jnp.float32) * scale

    return {
        'x': nrm(ks[0], (BATCH, SEQ, d), 1.0),
        'p': nrm(ks[1], (DEPTH, BATCH, SEQ, PLE_DIM), 1.0),
        'w_in': nrm(ks[2], (DEPTH, d, N_IN), d ** -0.5),
        'conv_w': nrm(ks[3], (DEPTH, CONV_K, CONV_WIDTH), CONV_K ** -0.5),
        'cmp_pos': nrm(ks[4], (DEPTH, 2, CMP_BLOCK, HEAD_DIM), 0.1),
        'cmp_w1': nrm(ks[5], (DEPTH, 2, CMP_BLOCK * HEAD_DIM, CMP_HIDDEN), (CMP_BLOCK * HEAD_DIM) ** -0.5),
        'cmp_b1': nrm(ks[6], (DEPTH, 2, CMP_HIDDEN), 0.01),
        'cmp_w2': nrm(ks[7], (DEPTH, 2, CMP_HIDDEN, HEAD_DIM), CMP_HIDDEN ** -0.5),
        'cmp_b2': nrm(ks[8], (DEPTH, 2, HEAD_DIM), 0.01),
        'sinks': nrm(ks[9], (DEPTH, SWA_Q_HEADS), 1.0),
        'w_branch': nrm(ks[10], (DEPTH, N_BRANCH, BRANCH_WIDTH, d), BRANCH_WIDTH ** -0.5 * BETA),
        'w_merge_gate': nrm(ks[11], (DEPTH, N_BRANCH, d, d), d ** -0.5),
        'b_merge_gate': nrm(ks[12], (DEPTH, N_BRANCH, d), 0.01),
        'w_out': nrm(ks[13], (DEPTH, d, d), d ** -0.5 * BETA),
        'ln_mix_g': 1.0 + nrm(ks[14], (DEPTH, d), 0.01),
        'ln_mix_b': nrm(ks[15], (DEPTH, d), 0.01),
        'ffn_w_gate': nrm(ks[16], (n_dense, d, D_FF), d ** -0.5),
        'ffn_w_up': nrm(ks[17], (n_dense, d, D_FF), d ** -0.5 * BETA),
        'ffn_w_down': nrm(ks[18], (n_dense, D_FF, d), D_FF ** -0.5 * BETA),
        'w_router': nrm(ks[19], (n_moe, d, N_EXPERTS), d ** -0.5),
        'b_router': nrm(ks[20], (n_moe, N_EXPERTS), 0.01),
        'moe_w_gate': nrm(ks[21], (n_moe, N_EXPERTS, d, D_FF_EXPERT), d ** -0.5),
        'moe_w_up': nrm(ks[22], (n_moe, N_EXPERTS, d, D_FF_EXPERT), d ** -0.5 * BETA),
        'moe_w_down': nrm(ks[23], (n_moe, N_EXPERTS, D_FF_EXPERT, d), D_FF_EXPERT ** -0.5 * BETA),
        'ple_w': nrm(ks[24], (DEPTH, PLE_DIM, d), PLE_DIM ** -0.5),
        'ple_gate_w': nrm(ks[25], (DEPTH, d, d), d ** -0.5),
        'ple_gate_b': nrm(ks[26], (DEPTH, d), 0.01),
        'ln_ffn_g': 1.0 + nrm(ks[27], (DEPTH, d), 0.01),
        'ln_ffn_b': nrm(ks[28], (DEPTH, d), 0.01),
    }


def reference(x, p, w_in, conv_w, cmp_pos, cmp_w1, cmp_b1, cmp_w2, cmp_b2, sinks, w_branch,
              w_merge_gate, b_merge_gate, w_out, ln_mix_g, ln_mix_b, ffn_w_gate, ffn_w_up, ffn_w_down,
              w_router, b_router, moe_w_gate, moe_w_up, moe_w_down, ple_w, ple_gate_w, ple_gate_b,
              ln_ffn_g, ln_ffn_b):
    for i in range(DEPTH):
        branches = token_mixers(x, w_in[i], conv_w[i], cmp_pos[i], cmp_w1[i], cmp_b1[i], cmp_w2[i],
                                cmp_b2[i], sinks[i])
        merged = jnp.zeros_like(x)
        for m in range(N_BRANCH):
            gate = jax.nn.sigmoid(x @ w_merge_gate[i, m] + b_merge_gate[i, m])
            merged = merged + gate * (branches[m] @ w_branch[i, m])
        x = layer_norm(ALPHA * x + merged @ w_out[i], ln_mix_g[i], ln_mix_b[i])
        j = i // 2
        if i % 2 == 0:
            f = swiglu(x, ffn_w_gate[j], ffn_w_up[j], ffn_w_down[j])
        else:
            f = moe_swiglu(x, w_router[j], b_router[j], moe_w_gate[j], moe_w_up[j], moe_w_down[j])
        ple = jax.nn.sigmoid(x @ ple_gate_w[i] + ple_gate_b[i]) * (p[i] @ ple_w[i])
        x = layer_norm(ALPHA * x + f + ple, ln_ffn_g[i], ln_ffn_b[i])
    return x
```

```cpp
#include <hip/hip_runtime.h>
#include <cstdio>
#include <cstdint>

#define GAS __attribute__((address_space(1)))
#define LAS __attribute__((address_space(3)))
typedef unsigned short bf16;
typedef short bf16x8 __attribute__((ext_vector_type(8)));
typedef short s16x4 __attribute__((ext_vector_type(4)));
typedef float f32x4 __attribute__((ext_vector_type(4)));
typedef unsigned u32x4 __attribute__((ext_vector_type(4)));
typedef unsigned u32x2 __attribute__((ext_vector_type(2)));
typedef GAS unsigned gu32;

constexpr int BATCH = 2, SEQ = 16384, T = BATCH * SEQ, D = 1024;
constexpr int NIN_SRC = 6418;
constexpr int ZP = 6400;
constexpr int NZ = 6656;
constexpr int BRW = 1536;
constexpr int DFF = 2816, NE = 8, DFE = 3584, PLED = 256;
constexpr float LN_EPS = 1e-5f;
constexpr float ALPHA = 1.4142135623730951f;
constexpr float LOG2E = 1.4426950408889634f, LN2 = 0.6931471805599453f;
constexpr int ZC_QA = 0, ZC_KA = 1152, ZC_VA = 2304, ZC_GB = 3456, ZC_GC = 3840, ZC_HB = 4224, ZC_QC = 4608, ZC_KW = 4992,
              ZC_VW = 5376, ZC_QD = 5504, ZC_KD = 5888, ZC_VD = 6016, ZC_GN = 6144;
constexpr int KVSP = 256;

__device__ __forceinline__ float bf2f(unsigned h) { return __builtin_bit_cast(float, h << 16); }
typedef float f32x2_t __attribute__((ext_vector_type(2)));
typedef __bf16 bf16x2_t __attribute__((ext_vector_type(2)));
__device__ __forceinline__ unsigned cvt_pk_bf16(float lo, float hi) { f32x2_t v = {lo, hi}; bf16x2_t b = __builtin_convertvector(v, bf16x2_t); return __builtin_bit_cast(unsigned, b); }
__device__ __forceinline__ float ex2(float x) { return __builtin_amdgcn_exp2f(x); }
__device__ __forceinline__ float rcpf(float x) { return __builtin_amdgcn_rcpf(x); }
__device__ __forceinline__ float sigmoidf_(float x) { return rcpf(1.f + ex2(-x * LOG2E)); }
__device__ __forceinline__ float siluf_(float x) { return x * sigmoidf_(x); }
__device__ __forceinline__ float gelu_tanh(float x) { const float y = 0.7978845608028654f * (x + 0.044715f * x * x * x); const float e = ex2(2.f * LOG2E * y); const float t = 1.f - 2.f * rcpf(1.f + e); return 0.5f * x * (1.f + t); }
__device__ __forceinline__ f32x4 unpack4(u32x2 w) { f32x4 r; r[0] = bf2f(w.x & 0xffffu); r[1] = bf2f(w.x >> 16); r[2] = bf2f(w.y & 0xffffu); r[3] = bf2f(w.y >> 16); return r; }
__device__ __forceinline__ u32x2 pack4(f32x4 v) { u32x2 w; w.x = cvt_pk_bf16(v[0], v[1]); w.y = cvt_pk_bf16(v[2], v[3]); return w; }
__device__ __forceinline__ bf16x8 pack8(f32x4 a, f32x4 b) { u32x4 w; w.x = cvt_pk_bf16(a[0], a[1]); w.y = cvt_pk_bf16(a[2], a[3]); w.z = cvt_pk_bf16(b[0], b[1]); w.w = cvt_pk_bf16(b[2], b[3]); return __builtin_bit_cast(bf16x8, w); }
__device__ __forceinline__ float wave_sum(float v) {
#pragma unroll
    for (int o = 1; o < 64; o <<= 1) v += __shfl_xor(v, o);
    return v;
}

__device__ __forceinline__ float quad_max(float m) {
    auto r = __builtin_amdgcn_permlane16_swap(__float_as_uint(m), __float_as_uint(m), false, false); m = fmaxf(__uint_as_float(r[0]), __uint_as_float(r[1]));
    auto q = __builtin_amdgcn_permlane32_swap(__float_as_uint(m), __float_as_uint(m), false, false); return fmaxf(__uint_as_float(q[0]), __uint_as_float(q[1]));
}
__device__ __forceinline__ float quad_sum(float m) {
    auto r = __builtin_amdgcn_permlane16_swap(__float_as_uint(m), __float_as_uint(m), false, false); m = __uint_as_float(r[0]) + __uint_as_float(r[1]);
    auto q = __builtin_amdgcn_permlane32_swap(__float_as_uint(m), __float_as_uint(m), false, false); return __uint_as_float(q[0]) + __uint_as_float(q[1]);
}

namespace pg8 {
constexpr int BM = 256, BK = 64, HALF = 128, HTB = HALF * BK * 2, STAGE_BYTES = 8 * HTB, NXCD = 8, WGM = 8;
__host__ __device__ __forceinline__ int lds_byte(int r, int c) { const int st = (r >> 4) * 2 + (c >> 5), rr = r & 15, cc = c & 31, ob = rr * 64 + cc * 2; return st * 1024 + (ob ^ (((ob >> 9) & 1) << 5)); }
__host__ __device__ __forceinline__ void stage_rc(int b, int& R, int& C) { const int st = b / 1024, sb = b % 1024, swz = sb ^ (((sb >> 9) & 1) << 5); R = (st >> 1) * 16 + swz / 64; C = (st & 1) * 32 + (swz % 64) / 2; }
__host__ __device__ __forceinline__ int perm32(int rho) { const int n = rho >> 4, i = rho & 15; return 8 * (i >> 2) + 4 * n + (i & 3); }

struct Unit { int pm, pn; };

struct StaticOrder {
    int nM, nN, nwg, G, c;
    __device__ __forceinline__ void init(int nM_, int nN_, int G_, int c_) { nM = nM_; nN = nN_; nwg = nM * nN; G = G_; c = c_; }
    __device__ __forceinline__ bool next(int i, Unit& u) const {
        const long L = (long)i * G + c; if (L >= nwg) return false;
        int wgid = (int)L; { const int q = nwg / NXCD, r = nwg % NXCD, xcd = wgid % NXCD, off = wgid / NXCD; wgid = (xcd < r ? xcd * (q + 1) : r * (q + 1) + (xcd - r) * q) + off; }
        const int nig = WGM * nN, gid = wgid / nig, fm = gid * WGM, gsz = (nM - fm) < WGM ? (nM - fm) : WGM;
        u.pm = fm + ((wgid % nig) % gsz); u.pn = (wgid % nig) / gsz; return true;
    }
};

template <class Epi, class Sched, bool ALIGN_EPI, bool GATH = false>
__device__ __forceinline__ void gemm_phase(LAS unsigned char* lds, const int K, const size_t lda, const Sched& S, const Epi& E) {
    int tid = threadIdx.x; asm volatile("" : "+v"(tid));
    const int wid = __builtin_amdgcn_readfirstlane(tid >> 6), lane = tid & 63, wr = wid >> 2, wc = wid & 3, fr = lane & 15, fq = lane >> 4;
    const int nt = K / BK;
    unsigned voffA[2], voffB[2];
#pragma unroll
    for (int i = 0; i < 2; ++i) { int R, C; stage_rc(tid * 16 + i * 8192, R, C); const int Rb = (R & ~31) + perm32(R & 31);
        voffA[i] = GATH ? (unsigned)(R * 4 + C * 2 * 65536) : (unsigned)((size_t)R * lda + C) * 2u; voffB[i] = (unsigned)(Rb * K + C) * 2u; }
    unsigned gv[2][2];
#define PG8_GLOAD(g, ord) do { _Pragma("unroll") for (int _h = 0; _h < 2; ++_h) _Pragma("unroll") for (int _i = 0; _i < 2; ++_i) \
        g[_h][_i] = (unsigned)(*(const LAS int*)((const LAS char*)S.lidx + (ord) * 1024 + _h * 512 + (voffA[_i] & 0xffffu))) * (unsigned)(lda * 2) + (voffA[_i] >> 16); } while (0)
    const size_t kstep = (size_t)(BK * 2);
    const size_t hstA = (size_t)HALF * lda * 2, hstB = (size_t)HALF * K * 2;
    const unsigned ldsw = (unsigned)wid * 1024u;
    const int aoff = lds_byte(wr * 64 + fr, fq * 8), boff = lds_byte(wc * 32 + fr, fq * 8);
#define PG8_SA(b, h) (((b) * 2 + (h)) * HTB)
#define PG8_SB(b, h) ((4 + (b) * 2 + (h)) * HTB)
#define PG8_STAGE(bufoff, gbase, voff) do { _Pragma("unroll") for (int _i = 0; _i < 2; ++_i) \
        __builtin_amdgcn_global_load_lds((const unsigned*)((const char*)(gbase) + (voff)[_i]), (LAS unsigned*)(lds + (bufoff) + ldsw + _i * 8192), 16, 0, 0); } while (0)
#define PG8_STAGE_A(bufoff, gbase, h, nx) do { if constexpr (GATH) { _Pragma("unroll") for (int _i = 0; _i < 2; ++_i) { \
        __builtin_amdgcn_global_load_lds((const unsigned*)((const char*)(gbase) + gv[h][_i]), (LAS unsigned*)(lds + (bufoff) + ldsw + _i * 8192), 16, 0, 0); } } \
    else { PG8_STAGE(bufoff, (gbase) + (h) * hstA, voffA); } } while (0)
#define PG8_LDA(dst, b, h) do { _Pragma("unroll") for (int m = 0; m < 4; ++m) _Pragma("unroll") for (int k = 0; k < 2; ++k) dst[m][k] = *(const LAS bf16x8*)(lds + PG8_SA(b, h) + aoff + m * 2048 + k * 1024); } while (0)
#define PG8_LDB(dst, b, h) do { _Pragma("unroll") for (int n = 0; n < 2; ++n) _Pragma("unroll") for (int k = 0; k < 2; ++k) dst[n][k] = *(const LAS bf16x8*)(lds + PG8_SB(b, h) + boff + n * 2048 + k * 1024); } while (0)
#define PG8_MMA(ai, bj, At, Bt) do { __builtin_amdgcn_s_setprio(1); _Pragma("unroll") for (int m = 0; m < 4; ++m) _Pragma("unroll") for (int n = 0; n < 2; ++n) _Pragma("unroll") for (int k = 0; k < 2; ++k) \
        acc[ai][bj][m][n] = __builtin_amdgcn_mfma_f32_16x16x32_bf16(Bt[n][k], At[m][k], acc[ai][bj][m][n], 0, 0, 0); __builtin_amdgcn_s_setprio(0); } while (0)
#define PG8_WAIT_V(n) asm volatile("s_waitcnt vmcnt(" #n ")" ::: "memory")
#define PG8_WAIT_L(n) asm volatile("s_waitcnt lgkmcnt(" #n ")" ::: "memory")
#define PG8_BAR __builtin_amdgcn_s_barrier()
#define PG8_SCHED __builtin_amdgcn_sched_barrier(0)
    Unit cur, nxt; int ui = 0;
    if (!S.next(0, cur)) return;
    f32x4 acc[2][2][4][2];
#pragma unroll
    for (int a = 0; a < 2; ++a)
#pragma unroll
        for (int b = 0; b < 2; ++b)
#pragma unroll
            for (int m = 0; m < 4; ++m)
#pragma unroll
                for (int n = 0; n < 2; ++n) acc[a][b][m][n] = (f32x4){0.f, 0.f, 0.f, 0.f};
    bf16x8 At[4][2], B0[2][2], B1[2][2];
    const char* cA = S.aptr(cur); const char* cB = S.bptr(cur);
    if constexpr (GATH) { PG8_GLOAD(gv, 0); }
    PG8_STAGE(PG8_SB(0, 0), cB, voffB); PG8_STAGE(PG8_SB(0, 1), cB + hstB, voffB); PG8_STAGE_A(PG8_SA(0, 0), cA, 0, false); PG8_STAGE_A(PG8_SA(0, 1), cA, 1, false);
    if (wr == 1) PG8_BAR;
    PG8_WAIT_V(2); PG8_BAR;
    PG8_STAGE(PG8_SB(1, 0), cB + kstep, voffB); PG8_STAGE_A(PG8_SA(1, 0), cA + kstep, 0, false); PG8_STAGE(PG8_SB(1, 1), cB + hstB + kstep, voffB);
    PG8_WAIT_V(6); PG8_BAR;
    for (;;) {
        const bool has_next = S.next(ui + 1, nxt);
        const char* nA = has_next ? S.aptr(nxt) : cA; const char* nB = has_next ? S.bptr(nxt) : cB;
#pragma nounroll
        for (int t = 0; t < nt; t += 2) {
            const bool last = (t == nt - 2);
            const char* a1 = cA + (size_t)(t + 1) * kstep;
            const char* a2 = last ? nA : cA + (size_t)(t + 2) * kstep; const char* b2 = last ? nB : cB + (size_t)(t + 2) * kstep;
            const char* a3 = a2 + kstep; const char* b3 = b2 + kstep;
            PG8_LDB(B0, 0, 0); PG8_LDB(B1, 0, 1); PG8_SCHED; PG8_LDA(At, 0, 0); PG8_STAGE_A(PG8_SA(1, 1), a1, 1, false); if constexpr (GATH) { if (last) { PG8_GLOAD(gv, has_next ? ui + 1 : ui); } }
            PG8_WAIT_V(8); PG8_WAIT_L(0); PG8_BAR; PG8_MMA(0, 0, At, B0); PG8_MMA(0, 1, At, B1); PG8_BAR; PG8_SCHED;
            PG8_LDA(At, 0, 1); PG8_STAGE(PG8_SB(0, 0), b2, voffB); PG8_STAGE(PG8_SB(0, 1), b2 + hstB, voffB); PG8_STAGE_A(PG8_SA(0, 0), a2, 0, last);
            PG8_WAIT_V(8); PG8_WAIT_L(0); PG8_BAR; PG8_MMA(1, 0, At, B0); PG8_MMA(1, 1, At, B1); PG8_BAR; PG8_SCHED;
            PG8_LDB(B0, 1, 0); PG8_LDB(B1, 1, 1); PG8_SCHED; PG8_LDA(At, 1, 0); PG8_STAGE_A(PG8_SA(0, 1), a2, 1, last);
            PG8_WAIT_V(8); PG8_WAIT_L(0); PG8_BAR; PG8_MMA(0, 0, At, B0); PG8_MMA(0, 1, At, B1); PG8_BAR; PG8_SCHED;
            PG8_LDA(At, 1, 1); PG8_STAGE(PG8_SB(1, 0), b3, voffB); PG8_STAGE(PG8_SB(1, 1), b3 + hstB, voffB); PG8_STAGE_A(PG8_SA(1, 0), a3, 0, last);
            PG8_WAIT_V(8); PG8_WAIT_L(0); PG8_BAR; PG8_MMA(1, 0, At, B0); PG8_MMA(1, 1, At, B1); PG8_BAR; PG8_SCHED;
        }
        if constexpr (ALIGN_EPI) { if (wr == 0) PG8_BAR; }
        PG8_SCHED; { int fr2 = fr, fq2 = fq; asm volatile("" : "+v"(fr2), "+v"(fq2)); E(acc, cur, wr, wc, fr2, fq2); } PG8_SCHED;
        if (!has_next) break;
#pragma unroll
        for (int a = 0; a < 2; ++a)
#pragma unroll
            for (int b = 0; b < 2; ++b)
#pragma unroll
                for (int m = 0; m < 4; ++m)
#pragma unroll
                    for (int n = 0; n < 2; ++n) acc[a][b][m][n] = (f32x4){0.f, 0.f, 0.f, 0.f};
        cur = nxt; cA = nA; cB = nB; ++ui;
        if constexpr (ALIGN_EPI) { if (wr == 1) PG8_BAR; }
    }
    PG8_WAIT_V(0);
    if constexpr (!ALIGN_EPI) { if (wr == 0) PG8_BAR; }
    PG8_BAR;
#undef PG8_SA
#undef PG8_SB
#undef PG8_STAGE
#undef PG8_STAGE_A
#undef PG8_GLOAD
#undef PG8_LDA
#undef PG8_LDB
#undef PG8_MMA
#undef PG8_WAIT_V
#undef PG8_WAIT_L
#undef PG8_BAR
#undef PG8_SCHED
}

struct SchedPlain : StaticOrder {
    const char* A; const char* B; size_t at, bt;
    __device__ __forceinline__ const char* aptr(const Unit& u) const { return A + (size_t)u.pm * at; }
    __device__ __forceinline__ const char* bptr(const Unit& u) const { return B + (size_t)u.pn * bt; }
};
struct SchedBproj : StaticOrder {
    const char* A; const char* B; size_t at, bt;
    __device__ __forceinline__ const char* aptr(const Unit& u) const { return A + (size_t)u.pm * at + (size_t)(u.pn >> 2) * 384 * 2; }
    __device__ __forceinline__ const char* bptr(const Unit& u) const { return B + (size_t)u.pn * bt; }
};
struct SchedUp0 : StaticOrder {
    const char* A; const char* B; const char* B2; size_t at, bt; int nup;
    __device__ __forceinline__ const char* aptr(const Unit& u) const { return A + (size_t)u.pm * at; }
    __device__ __forceinline__ const char* bptr(const Unit& u) const { return u.pn < nup ? B + (size_t)u.pn * bt : B2 + (size_t)(u.pn - nup) * bt; }
};
struct SchedCmp {
    const char* A; const char* B; int G, c;
    __device__ __forceinline__ bool next(int i, Unit& u) const { const int L = i * G + c; if (L >= 32) return false; u.pm = L; u.pn = 0; return true; }
    __device__ __forceinline__ const char* aptr(const Unit& u) const { const int L = u.pm, kv2 = L >> 4, seg = (L >> 2) & 3, mt = L & 3, b = seg >> 1, kv = seg & 1;
        return A + ((size_t)((b * 4 + kv2 * 2 + kv)) * SEQ * 64 + (size_t)mt * 256 * 1024) * 2; }
    __device__ __forceinline__ const char* bptr(const Unit& u) const { return B + (size_t)(u.pm >> 4) * 256 * 2048 * 2; }
};
struct SchedMoe {
    const char* A; const char* B; size_t at, bt_tile, bt_exp; int G, c, nN, tile0, ntile; const LAS int* seg;
    __device__ __forceinline__ bool next(int i, Unit& u) const { const int L = i * G + c; if (L >= ntile * nN) return false; u.pm = tile0 + L / nN; u.pn = L % nN; return true; }
    __device__ __forceinline__ int expert(int pm) const { const int r0 = pm * 256; int e = 0;
#pragma unroll
        for (int j = 1; j < NE; ++j) e += (seg[j] <= r0) ? 1 : 0;
        return __builtin_amdgcn_readfirstlane(e); }
    __device__ __forceinline__ const char* aptr(const Unit& u) const { return A + (size_t)(u.pm - tile0) * at; }
    __device__ __forceinline__ const char* bptr(const Unit& u) const { return B + (size_t)expert(u.pm) * bt_exp + (size_t)u.pn * bt_tile; }
};

struct SchedMoeG : SchedMoe {
    const LAS int* lidx;
    __device__ __forceinline__ const char* aptr(const Unit&) const { return A; }
};

#define EPI_ARGS const f32x4 (&acc)[2][2][4][2], const Unit& u, int wr, int wc, int fr, int fq
struct EpiZ {
    bf16* Z; bf16* CMP; bf16* KVS;
    __device__ __forceinline__ void operator()(EPI_ARGS) const {
        const int row0 = u.pm * BM + wr * 64 + fr;
        if (u.pn == 20) {
#pragma unroll
            for (int ai = 0; ai < 2; ++ai)
#pragma unroll
                for (int m = 0; m < 4; ++m) { bf16* rowp = KVS + (size_t)(row0 + ai * HALF + m * 16) * KVSP + wc * 32 + 8 * fq;
#pragma unroll
                    for (int bj = 0; bj < 2; ++bj) *(GAS bf16x8*)(rowp + bj * HALF) = pack8(acc[ai][bj][m][0], acc[ai][bj][m][1]); }
        } else if (u.pn < 25) {
#pragma unroll
            for (int ai = 0; ai < 2; ++ai)
#pragma unroll
                for (int m = 0; m < 4; ++m) { bf16* rowp = Z + (size_t)(row0 + ai * HALF + m * 16) * ZP + u.pn * BM + wc * 32 + 8 * fq;
#pragma unroll
                    for (int bj = 0; bj < 2; ++bj) *(GAS bf16x8*)(rowp + bj * HALF) = pack8(acc[ai][bj][m][0], acc[ai][bj][m][1]); }
        } else {
#pragma unroll
            for (int ai = 0; ai < 2; ++ai)
#pragma unroll
                for (int m = 0; m < 4; ++m) { const int row = row0 + ai * HALF + m * 16, b = row >> 14, t = row & (SEQ - 1);
#pragma unroll
                    for (int bj = 0; bj < 2; ++bj) { const int lc = bj * HALF + wc * 32 + 8 * fq, hh = lc >> 6, d = lc & 63;
                        *(GAS bf16x8*)(CMP + ((size_t)(b * 4 + hh) * SEQ + t) * 64 + d) = pack8(acc[ai][bj][m][0], acc[ai][bj][m][1]); } }
        }
    }
};
struct EpiBf16 {
    bf16* O; int ldc;
    __device__ __forceinline__ void operator()(EPI_ARGS) const {
        const int row0 = u.pm * BM + wr * 64 + fr;
#pragma unroll
        for (int ai = 0; ai < 2; ++ai)
#pragma unroll
            for (int m = 0; m < 4; ++m) { bf16* rowp = O + (size_t)(row0 + ai * HALF + m * 16) * ldc + u.pn * BM + wc * 32 + 8 * fq;
#pragma unroll
                for (int bj = 0; bj < 2; ++bj) *(GAS bf16x8*)(rowp + bj * HALF) = pack8(acc[ai][bj][m][0], acc[ai][bj][m][1]); }
    }
};
struct EpiGateSum {
    const bf16* BP; const float* bg; bf16* MG;
    __device__ __forceinline__ void operator()(EPI_ARGS) const {
        const int row0 = u.pm * BM + wr * 64 + fr, c0 = 64 * u.pn + 16 * wc + 4 * fq;
        f32x4 bgv[4];
#pragma unroll
        for (int mm = 0; mm < 4; ++mm) bgv[mm] = *(const GAS f32x4*)(bg + mm * D + c0);
#pragma unroll
        for (int ai = 0; ai < 2; ++ai)
#pragma unroll
            for (int m = 0; m < 4; ++m) { const size_t row = (size_t)(row0 + ai * HALF + m * 16); f32x4 sum = {0.f, 0.f, 0.f, 0.f};
#pragma unroll
                for (int bj = 0; bj < 2; ++bj)
#pragma unroll
                    for (int n = 0; n < 2; ++n) { const int mm = 2 * bj + n; const f32x4 a = acc[ai][bj][m][n] + bgv[mm];
                        const f32x4 bp = unpack4(*(const GAS u32x2*)(BP + row * 4096 + mm * D + c0));
#pragma unroll
                        for (int i = 0; i < 4; ++i) sum[i] += sigmoidf_(a[i]) * bp[i]; }
                *(GAS u32x2*)(MG + row * D + c0) = pack4(sum); }
    }
};
struct EpiResid {
    const float* xin; float* out;
    __device__ __forceinline__ void operator()(EPI_ARGS) const {
        const int row0 = u.pm * BM + wr * 64 + fr, col0 = u.pn * BM + wc * 32 + 8 * fq;
#pragma unroll
        for (int ai = 0; ai < 2; ++ai)
#pragma unroll
            for (int m = 0; m < 4; ++m) { const size_t ro = (size_t)(row0 + ai * HALF + m * 16) * D + col0;
#pragma unroll
                for (int bj = 0; bj < 2; ++bj)
#pragma unroll
                    for (int n = 0; n < 2; ++n) { const f32x4 xv = *(const GAS f32x4*)(xin + ro + bj * HALF + 4 * n);
                        *(GAS f32x4*)(out + ro + bj * HALF + 4 * n) = xv * ALPHA + acc[ai][bj][m][n]; } }
    }
};
struct EpiUp {
    bf16* H; int ldh; int nup; int row_off; const float* pgb; bf16* PW;
    __device__ __forceinline__ void operator()(EPI_ARGS) const {
        const int row0 = u.pm * BM + wr * 64 + fr;
        if (u.pn < nup) {
            const int f0 = 128 * u.pn + 32 * wc + 8 * fq;
#pragma unroll
            for (int ai = 0; ai < 2; ++ai)
#pragma unroll
                for (int m = 0; m < 4; ++m) { f32x4 h[2];
#pragma unroll
                    for (int n = 0; n < 2; ++n)
#pragma unroll
                        for (int i = 0; i < 4; ++i) h[n][i] = siluf_(acc[ai][0][m][n][i]) * acc[ai][1][m][n][i];
                    *(GAS bf16x8*)(H + (size_t)(row0 + ai * HALF + m * 16 - row_off) * ldh + f0) = pack8(h[0], h[1]); }
        } else {
            const int q = u.pn - nup;
#pragma unroll
            for (int bj = 0; bj < 2; ++bj) { const int col = 256 * q + 128 * bj + 32 * wc + 8 * fq; const f32x4 b0 = *(const GAS f32x4*)(pgb + col), b1 = *(const GAS f32x4*)(pgb + col + 4);
#pragma unroll
                for (int ai = 0; ai < 2; ++ai)
#pragma unroll
                    for (int m = 0; m < 4; ++m) { bf16* p = PW + (size_t)(row0 + ai * HALF + m * 16) * D + col; const u32x4 w = *(const GAS u32x4*)p;
                        const f32x4 p0 = unpack4((u32x2){w.x, w.y}), p1 = unpack4((u32x2){w.z, w.w}); f32x4 r0, r1;
#pragma unroll
                        for (int i = 0; i < 4; ++i) { r0[i] = sigmoidf_(acc[ai][bj][m][0][i] + b0[i]) * p0[i]; r1[i] = sigmoidf_(acc[ai][bj][m][1][i] + b1[i]) * p1[i]; }
                        *(GAS bf16x8*)p = pack8(r0, r1); } }
        }
    }
};
struct EpiDown {
    bf16* out; const bf16* PL;
    __device__ __forceinline__ void operator()(EPI_ARGS) const {
        const int row0 = u.pm * BM + wr * 64 + fr, col0 = u.pn * BM + wc * 32 + 8 * fq;
#pragma unroll
        for (int ai = 0; ai < 2; ++ai)
#pragma unroll
            for (int m = 0; m < 4; ++m) { const size_t ro = (size_t)(row0 + ai * HALF + m * 16) * D + col0;
#pragma unroll
                for (int bj = 0; bj < 2; ++bj) { const u32x4 w = *(const GAS u32x4*)(PL + ro + bj * HALF); const f32x4 p0 = unpack4((u32x2){w.x, w.y}), p1 = unpack4((u32x2){w.z, w.w});
                    const u32x4 xw = *(const GAS u32x4*)(out + ro + bj * HALF); const f32x4 x0 = unpack4((u32x2){xw.x, xw.y}), x1 = unpack4((u32x2){xw.z, xw.w});
                    const u32x2 r0 = pack4(x0 * ALPHA + acc[ai][bj][m][0] + p0), r1 = pack4(x1 * ALPHA + acc[ai][bj][m][1] + p1);
                    *(GAS u32x4*)(out + ro + bj * HALF) = (u32x4){r0.x, r0.y, r1.x, r1.y}; } }
    }
};
struct EpiMoeDown {
    bf16* Y; const float* roww;
    __device__ __forceinline__ void operator()(EPI_ARGS) const {
        const int row0 = u.pm * BM + wr * 64 + fr;
#pragma unroll
        for (int ai = 0; ai < 2; ++ai)
#pragma unroll
            for (int m = 0; m < 4; ++m) { const int row = row0 + ai * HALF + m * 16; const float w = roww[row]; bf16* rowp = Y + (size_t)row * D + u.pn * BM + wc * 32 + 8 * fq;
#pragma unroll
                for (int bj = 0; bj < 2; ++bj) *(GAS bf16x8*)(rowp + bj * HALF) = pack8(acc[ai][bj][m][0] * w, acc[ai][bj][m][1] * w); }
    }
};
struct EpiHid {
    bf16* HID; const float* b1p;
    __device__ __forceinline__ void operator()(EPI_ARGS) const {
        const int L = u.pm, kv2 = L >> 4, seg = (L >> 2) & 3, mt = L & 3; const int rb = kv2 * 4096 + seg * 1024 + mt * 256 + wr * 64 + fr, col = wc * 32 + 8 * fq;
        const f32x4 b0 = *(const GAS f32x4*)(b1p + kv2 * 128 + col), b1 = *(const GAS f32x4*)(b1p + kv2 * 128 + col + 4);
#pragma unroll
        for (int ai = 0; ai < 2; ++ai)
#pragma unroll
            for (int m = 0; m < 4; ++m) { f32x4 r0, r1;
#pragma unroll
                for (int i = 0; i < 4; ++i) { r0[i] = gelu_tanh(acc[ai][0][m][0][i] + b0[i]); r1[i] = gelu_tanh(acc[ai][0][m][1][i] + b1[i]); }
                *(GAS bf16x8*)(HID + (size_t)(rb + ai * HALF + m * 16) * 128 + col) = pack8(r0, r1); }
    }
};
#undef EPI_ARGS
}

namespace att {
constexpr int RS = 144;
constexpr int TILE_B = 64 * RS;
constexpr int OFF_IMP = 4 * TILE_B;
constexpr int IMP_RS = 528;
constexpr int OFF_PART = 4 * 2 * TILE_B;
constexpr int OFF_SEL = OFF_PART + 8 * 6144;
constexpr int LDS_END = OFF_SEL + 128 * 32;
static_assert(OFF_IMP + 128 * IMP_RS <= OFF_SEL, "importance rows end below the selection masks");
constexpr float SC2 = 0.125f * LOG2E;
constexpr float NEG_INF = -__builtin_inff();

template <int NB> struct AState { f32x4 o[NB][4]; f32x4 la[NB]; float m[NB]; };
template <int NB> __device__ __forceinline__ void state_init(AState<NB>& A) {
#pragma unroll
    for (int nb = 0; nb < NB; ++nb) { A.m[nb] = -1e30f; A.la[nb] = (f32x4){0.f, 0.f, 0.f, 0.f};
#pragma unroll
        for (int dt = 0; dt < 4; ++dt) A.o[nb][dt] = (f32x4){0.f, 0.f, 0.f, 0.f}; }
}
struct KVRegs { u32x4 k, v; };
__device__ __forceinline__ void kv_issue(KVRegs& r, const bf16* kp, const bf16* vp) { r.k = *(const GAS u32x4*)kp; r.v = *(const GAS u32x4*)vp; }
__device__ __forceinline__ void kv_commit(LAS unsigned char* lds, int buf, const KVRegs& r, int tid) {
    LAS unsigned char* p = lds + buf * 2 * TILE_B + (tid >> 3) * RS + (tid & 7) * 16;
    *(LAS u32x4*)p = r.k; *(LAS u32x4*)(p + TILE_B) = r.v;
}
template <int NB> __device__ __forceinline__ void qk_tile(f32x4 (&st)[NB][4], const LAS unsigned char* Kl, const bf16x8 (&qf)[NB][2], int fr, int fq) {
    __builtin_amdgcn_s_setprio(1);
#pragma unroll
    for (int sub = 0; sub < 4; ++sub) {
#pragma unroll
        for (int nb = 0; nb < NB; ++nb) st[nb][sub] = (f32x4){0.f, 0.f, 0.f, 0.f};
#pragma unroll
        for (int ks = 0; ks < 2; ++ks) { const bf16x8 kf = *(const LAS bf16x8*)(Kl + (sub * 16 + fr) * RS + ks * 64 + fq * 16);
#pragma unroll
            for (int nb = 0; nb < NB; ++nb) st[nb][sub] = __builtin_amdgcn_mfma_f32_16x16x32_bf16(kf, qf[nb][ks], st[nb][sub], 0, 0, 0); }
    }
    __builtin_amdgcn_s_setprio(0);
}
template <int NB> __device__ __forceinline__ void pv_tile(f32x4 (&o)[NB][4], const LAS unsigned char* Vl, const bf16x8 (&pf)[NB][2], int fr, int fq) {
    __builtin_amdgcn_s_setprio(1);
#pragma unroll
    for (int kk = 0; kk < 2; ++kk)
#pragma unroll
        for (int dt = 0; dt < 4; ++dt) {
            const LAS unsigned char* p = Vl + (32 * kk + 4 * fq + (fr >> 2)) * RS + (dt * 16 + 4 * (fr & 3)) * 2;
            const s16x4 lo = __builtin_amdgcn_ds_read_tr16_b64_v4i16((LAS s16x4*)p);
            const s16x4 hi = __builtin_amdgcn_ds_read_tr16_b64_v4i16((LAS s16x4*)(p + 16 * RS));
            const bf16x8 vf = __builtin_shufflevector(lo, hi, 0, 1, 2, 3, 4, 5, 6, 7);
#pragma unroll
            for (int nb = 0; nb < NB; ++nb) o[nb][dt] = __builtin_amdgcn_mfma_f32_16x16x32_bf16(vf, pf[nb][kk], o[nb][dt], 0, 0, 0);
        }
    __builtin_amdgcn_s_setprio(0);
}
template <int NB, bool EMASK, bool DO_PV> __device__ __forceinline__ void attn_tile(AState<NB>& A, const LAS unsigned char* Kl, const LAS unsigned char* Vl, const bf16x8 (&qf)[NB][2],
                                                            int kp0, const int (&lo)[NB], const int (&hi)[NB], float lane_bias, int fr, int fq) {
    f32x4 st[NB][4];
    qk_tile<NB>(st, Kl, qf, fr, fq);
    float alpha[NB], nbias[NB]; bool moved = false;
#pragma unroll
    for (int nb = 0; nb < NB; ++nb) {
        float mx = NEG_INF;
#pragma unroll
        for (int sub = 0; sub < 4; ++sub)
#pragma unroll
            for (int r = 0; r < 4; ++r) {
                if constexpr (EMASK) { const int kpos = kp0 + sub * 16 + 4 * fq + r; st[nb][sub][r] = (kpos >= lo[nb] && kpos <= hi[nb]) ? st[nb][sub][r] : NEG_INF; }
                mx = fmaxf(mx, st[nb][sub][r]); }
        mx = quad_max(mx);
        const float mnew = fmaxf(A.m[nb], __builtin_fmaf(mx, SC2, lane_bias)); nbias[nb] = lane_bias - mnew; alpha[nb] = ex2(A.m[nb] - mnew); moved = moved || (mnew != A.m[nb]); A.m[nb] = mnew;
    }
    if (__any(moved)) {
#pragma unroll
        for (int nb = 0; nb < NB; ++nb) { A.la[nb] = A.la[nb] * alpha[nb];
            if constexpr (DO_PV) {
#pragma unroll
                for (int dt = 0; dt < 4; ++dt) A.o[nb][dt] = A.o[nb][dt] * alpha[nb]; } }
    }
    bf16x8 vf[2][4];
    if constexpr (DO_PV) {
#pragma unroll
        for (int dt = 0; dt < 4; ++dt) {
            const LAS unsigned char* p = Vl + (4 * fq + (fr >> 2)) * RS + (dt * 16 + 4 * (fr & 3)) * 2;
            const s16x4 lo4 = __builtin_amdgcn_ds_read_tr16_b64_v4i16((LAS s16x4*)p);
            const s16x4 hi4 = __builtin_amdgcn_ds_read_tr16_b64_v4i16((LAS s16x4*)(p + 16 * RS));
            vf[0][dt] = __builtin_shufflevector(lo4, hi4, 0, 1, 2, 3, 4, 5, 6, 7); }
#pragma unroll
        for (int dt = 0; dt < 4; ++dt) {
            const LAS unsigned char* p = Vl + (32 + 4 * fq + (fr >> 2)) * RS + (dt * 16 + 4 * (fr & 3)) * 2;
            const s16x4 lo4 = __builtin_amdgcn_ds_read_tr16_b64_v4i16((LAS s16x4*)p);
            const s16x4 hi4 = __builtin_amdgcn_ds_read_tr16_b64_v4i16((LAS s16x4*)(p + 16 * RS));
            vf[1][dt] = __builtin_shufflevector(lo4, hi4, 0, 1, 2, 3, 4, 5, 6, 7); }
    }
    bf16x8 pf[NB][2];
#pragma unroll
    for (int nb = 0; nb < NB; ++nb) {
#pragma unroll
        for (int sub = 0; sub < 4; ++sub)
#pragma unroll
            for (int r = 0; r < 4; ++r) st[nb][sub][r] = ex2(__builtin_fmaf(st[nb][sub][r], SC2, nbias[nb]));
        pf[nb][0] = pack8(st[nb][0], st[nb][1]); pf[nb][1] = pack8(st[nb][2], st[nb][3]);
    }
    __builtin_amdgcn_s_setprio(1);
    { const bf16x8 ones = {0x3F80, 0x3F80, 0x3F80, 0x3F80, 0x3F80, 0x3F80, 0x3F80, 0x3F80};
#pragma unroll
      for (int kk = 0; kk < 2; ++kk)
#pragma unroll
        for (int nb = 0; nb < NB; ++nb) A.la[nb] = __builtin_amdgcn_mfma_f32_16x16x32_bf16(ones, pf[nb][kk], A.la[nb], 0, 0, 0); }
    if constexpr (DO_PV) {
#pragma unroll
        for (int kk = 0; kk < 2; ++kk)
#pragma unroll
            for (int dt = 0; dt < 4; ++dt)
#pragma unroll
                for (int nb = 0; nb < NB; ++nb) A.o[nb][dt] = __builtin_amdgcn_mfma_f32_16x16x32_bf16(vf[kk][dt], pf[nb][kk], A.o[nb][dt], 0, 0, 0);
    }
    __builtin_amdgcn_s_setprio(0);
}

template <int NB> struct BandedArgs {
    const bf16* Q; const bf16* K; const bf16* V; int pitch;
    int tok0, dil;
    int p0, W;
    int qcol_nb, qrow_nb, rpw;
    bf16* O; int opitch, ocol_nb;
    float* lse; int lse_stride;
    const float* sink;
};
template <int NB> __device__ __forceinline__ void banded_unit(LAS unsigned char* lds, const BandedArgs<NB>& a) {
    int tid = threadIdx.x; asm volatile("" : "+v"(tid));
    const int wave = __builtin_amdgcn_readfirstlane(tid >> 6), lane = tid & 63, fr = lane & 15, fq = lane >> 4;
    const int wq0 = a.p0 + wave * a.rpw;
    bf16x8 qf[NB][2]; int qpos[NB], lo[NB];
#pragma unroll
    for (int nb = 0; nb < NB; ++nb) { qpos[nb] = wq0 + nb * a.qrow_nb + fr; lo[nb] = qpos[nb] - a.W;
        const bf16* qp = a.Q + (size_t)(a.tok0 + a.dil * qpos[nb]) * a.pitch + nb * a.qcol_nb + fq * 8;
        qf[nb][0] = *(const GAS bf16x8*)qp; qf[nb][1] = *(const GAS bf16x8*)(qp + 32); }
    AState<NB> A; state_init<NB>(A);
    int kstart = a.p0 - a.W; kstart = kstart < 0 ? 0 : (kstart & ~63);
    const int nt = (a.p0 + 8 * a.rpw - kstart) >> 6;
    const int wlo = wq0 - a.W, whi = wq0 + a.rpw - 1;
    const int srow = tid >> 3, sch = tid & 7;
    KVRegs r, r1;
    { const size_t ro = (size_t)(a.tok0 + a.dil * (kstart + srow)) * a.pitch + sch * 8; kv_issue(r, a.K + ro, a.V + ro); }
    if (nt > 1) { const size_t ro = (size_t)(a.tok0 + a.dil * (kstart + 64 + srow)) * a.pitch + sch * 8; kv_issue(r1, a.K + ro, a.V + ro); }
    kv_commit(lds, 0, r, tid);
    if (nt > 1) kv_commit(lds, 1, r1, tid);
    __syncthreads();
    int tA = (wlo - kstart) >> 6; tA = tA < 0 ? 0 : tA;
    int tB = (whi - kstart) >> 6; tB = tB > nt - 1 ? nt - 1 : tB;
    int tF0 = (whi - a.W - kstart + 63) >> 6; tF0 = tF0 < tA ? tA : tF0;
    int tF1 = (wq0 - 63 - kstart) >> 6; tF1 = tF1 > tB ? tB : tF1;
    if (tF1 < tF0) { tF0 = tB + 1; tF1 = tB; }
#define BAND_ITER(...) { const int kp0 = kstart + 64 * t; \
        if (!(t & 1)) { \
            if (t + 2 < nt) { const size_t ro = (size_t)(a.tok0 + a.dil * (kp0 + 128 + srow)) * a.pitch + sch * 8; kv_issue(r, a.K + ro, a.V + ro); } \
            if (t + 3 < nt) { const size_t ro = (size_t)(a.tok0 + a.dil * (kp0 + 192 + srow)) * a.pitch + sch * 8; kv_issue(r1, a.K + ro, a.V + ro); } } \
        { const LAS unsigned char* Kl = lds + (t & 3) * 2 * TILE_B; (void)Kl; __VA_ARGS__ } \
        if (t & 1) { if (t + 1 < nt) kv_commit(lds, (t + 1) & 3, r, tid); if (t + 2 < nt) kv_commit(lds, (t + 2) & 3, r1, tid); } \
        if ((t & 1) || t == nt - 1) __syncthreads(); }
    int t = 0;
    for (; t < tA; ++t) BAND_ITER(;)
    for (; t < tF0; ++t) BAND_ITER((attn_tile<NB, true, true>(A, Kl, Kl + TILE_B, qf, kp0, lo, qpos, 0.f, fr, fq));)
    for (; t <= tF1; ++t) BAND_ITER((attn_tile<NB, false, true>(A, Kl, Kl + TILE_B, qf, kp0, lo, qpos, 0.f, fr, fq));)
    for (; t <= tB; ++t) BAND_ITER((attn_tile<NB, true, true>(A, Kl, Kl + TILE_B, qf, kp0, lo, qpos, 0.f, fr, fq));)
    for (; t < nt; ++t) BAND_ITER(;)
#undef BAND_ITER
#pragma unroll
    for (int nb = 0; nb < NB; ++nb) {
        const float lt = A.la[nb][0];
        const float lse = (A.m[nb] + __builtin_amdgcn_logf(lt)) * LN2;
        float sc = 1.f / lt;
        if (a.sink) sc *= sigmoidf_(lse - a.sink[nb]);
        const size_t tok = (size_t)(a.tok0 + a.dil * qpos[nb]);
        bf16* op = a.O + tok * a.opitch + nb * a.ocol_nb + 4 * fq;
#pragma unroll
        for (int dt = 0; dt < 4; ++dt) *(GAS u32x2*)(op + dt * 16) = pack4(A.o[nb][dt] * sc);
        if (a.lse && fq == 0) a.lse[tok * a.lse_stride] = lse;
    }
}

__device__ __forceinline__ void nsa_unit(LAS unsigned char* lds, const bf16* Z, const bf16* KVS, const bf16* KC, const bf16* VC, const bf16* BR, bf16* BRO, int b, int kv, int t0) {
    int tid = threadIdx.x; asm volatile("" : "+v"(tid));
    const int wave = __builtin_amdgcn_readfirstlane(tid >> 6), lane = tid & 63, fr = lane & 15, fq = lane >> 4;
    const int tq = t0 + wave * 16 + fr; const size_t gt = (size_t)b * SEQ + tq;
    const int srow = tid >> 3, sch = tid & 7;
    bf16x8 qf[3][2];
#pragma unroll
    for (int g = 0; g < 3; ++g) { const bf16* qp = Z + gt * ZP + ZC_QC + (kv * 3 + g) * 64 + fq * 8; qf[g][0] = *(const GAS bf16x8*)qp; qf[g][1] = *(const GAS bf16x8*)(qp + 32); }
    const int cm = (tq - 31) >> 4;
    const int ntc = (((t0 + 96) >> 4) >> 6) + 1;
    const int cmw = (t0 + wave * 16 + 15 - 31) >> 4;
    KVRegs r;
    AState<3> A; state_init<3>(A);
    int lo3[3], hi3[3];
#pragma unroll
    for (int g = 0; g < 3; ++g) { lo3[g] = 0; hi3[g] = cm; }
    const int cmin_w = (t0 + wave * 16 - 31) >> 4;
    kv_issue(r, KC + (size_t)srow * 64 + sch * 8, VC + (size_t)srow * 64 + sch * 8);
    kv_commit(lds, 0, r, tid);
    __syncthreads();
    int tcF = cmin_w < 63 ? 0 : ((cmin_w - 63) >> 6) + 1;
    int tcB = cmw < 0 ? 0 : (cmw >> 6) + 1;
    tcF = tcF > ntc ? ntc : tcF; tcB = tcB > ntc ? ntc : tcB; tcB = tcB < tcF ? tcF : tcB;
#define CMP_ITER(...) { const int c0 = 64 * t; \
        if (t + 1 < ntc) { const size_t ro = (size_t)(c0 + 64 + srow) * 64 + sch * 8; kv_issue(r, KC + ro, VC + ro); } \
        { const LAS unsigned char* Kl = lds + (t & 1) * 2 * TILE_B; (void)Kl; __VA_ARGS__ } \
        if (t + 1 < ntc) kv_commit(lds, (t + 1) & 1, r, tid); \
        __syncthreads(); }
    { int t = 0;
      for (; t < tcF; ++t) CMP_ITER((attn_tile<3, false, false>(A, Kl, Kl + TILE_B, qf, c0, lo3, hi3, 0.f, fr, fq));)
      for (; t < tcB; ++t) CMP_ITER((attn_tile<3, true, false>(A, Kl, Kl + TILE_B, qf, c0, lo3, hi3, 0.f, fr, fq));)
      for (; t < ntc; ++t) CMP_ITER(;) }
    float linv[3], m1[3];
#pragma unroll
    for (int g = 0; g < 3; ++g) { const float lt = A.la[g][0]; linv[g] = lt > 0.f ? 1.f / lt : 0.f; m1[g] = A.m[g]; }
    { LAS unsigned* ip = (LAS unsigned*)(lds + OFF_IMP + wave * 16 * IMP_RS);
        for (int i = lane; i < 16 * IMP_RS / 4; i += 64) ip[i] = 0u; }
    state_init<3>(A);
    kv_issue(r, KC + (size_t)srow * 64 + sch * 8, VC + (size_t)srow * 64 + sch * 8);
    kv_commit(lds, 0, r, tid);
    __syncthreads();
    float bprev = 0.f;
    for (int t = 0; t < ntc; ++t) {
        const int c0 = 64 * t;
        if (t + 1 < ntc) { const size_t ro = (size_t)(c0 + 64 + srow) * 64 + sch * 8; kv_issue(r, KC + ro, VC + ro); }
        if (c0 <= cmw) {
            const LAS unsigned char* Kl = lds + (t & 1) * 2 * TILE_B;
            f32x4 st[3][4];
            qk_tile<3>(st, Kl, qf, fr, fq);
            bf16x8 pf[3][2];
#pragma unroll
            for (int g = 0; g < 3; ++g) {
#pragma unroll
                for (int sub = 0; sub < 4; ++sub)
#pragma unroll
                    for (int q = 0; q < 4; ++q) { const int c = c0 + sub * 16 + 4 * fq + q; st[g][sub][q] = (c <= cm) ? ex2(__builtin_fmaf(st[g][sub][q], SC2, -m1[g])) : 0.f; }
                pf[g][0] = pack8(st[g][0], st[g][1]); pf[g][1] = pack8(st[g][2], st[g][3]);
            }
#pragma unroll
            for (int sub = 0; sub < 4; ++sub) {
                float av = 0.f, bcur = 0.f;
#pragma unroll
                for (int g = 0; g < 3; ++g) { av += linv[g] * ((st[g][sub][0] + st[g][sub][1]) + (st[g][sub][2] + st[g][sub][3])); bcur += linv[g] * st[g][sub][3]; }
                const int src = (lane + 48) & 63;
                const float x1 = __shfl(bcur, src), x2 = __shfl(bprev, src);
                const float bsel = (fq == 0) ? x2 : x1;
                bprev = bcur;
                const int j = t * 16 + sub * 4 + fq;
                *(LAS _Float16*)(lds + OFF_IMP + (wave * 16 + fr) * IMP_RS + j * 2) = (_Float16)(av + bsel);
            }
            pv_tile<3>(A.o, Kl + TILE_B, pf, fr, fq);
        }
        if (t + 1 < ntc) kv_commit(lds, (t + 1) & 1, r, tid);
        __syncthreads();
    }
    u32x2 part[3][4];
    {
        const bf16* gp = Z + gt * ZP + ZC_GN;
#pragma unroll
        for (int g = 0; g < 3; ++g) {
            const int h = kv * 3 + g;
            const float gc = sigmoidf_(bf2f(gp[h])), gw = sigmoidf_(bf2f(gp[12 + h]));
            const bf16* wp = BR + gt * BRW + 768 + h * 64 + 4 * fq;
#pragma unroll
            for (int dt = 0; dt < 4; ++dt) { const f32x4 ow = unpack4(*(const GAS u32x2*)(wp + dt * 16)); part[g][dt] = pack4(A.o[g][dt] * (linv[g] * gc) + ow * gw); }
        }
    }
    __builtin_amdgcn_wave_barrier(); asm volatile("s_waitcnt lgkmcnt(0)" ::: "memory");
    for (int qi = 0; qi < 16; ++qi) {
        const int tqq = t0 + wave * 16 + qi, cur = tqq >> 6;
        const LAS unsigned short* ir = (const LAS unsigned short*)(lds + OFF_IMP + (wave * 16 + qi) * IMP_RS);
        const int j0 = lane, j1 = lane + 64, j2 = lane + 128, j3 = lane + 192, f2 = cur - 1;
        const bool fo0 = (j0 == 0) || (j0 == cur) || (j0 == f2), fo1 = (j1 == cur) || (j1 == f2), fo2 = (j2 == cur) || (j2 == f2), fo3 = (j3 == cur) || (j3 == f2);
        const unsigned k0 = (j0 <= cur && !fo0) ? (unsigned)ir[j0] + 1u : 0u, k1 = (j1 <= cur && !fo1) ? (unsigned)ir[j1] + 1u : 0u;
        const unsigned k2 = (j2 <= cur && !fo2) ? (unsigned)ir[j2] + 1u : 0u, k3 = (j3 <= cur && !fo3) ? (unsigned)ir[j3] + 1u : 0u;
        const int nforced = cur >= 2 ? 3 : cur + 1, ntot = cur + 1 < 16 ? cur + 1 : 16, npick = ntot - nforced;
        unsigned T = 0xffffffffu;
        if (npick > 0) { T = 0u;
            for (int b = 14; b >= 0; --b) { const unsigned c = T | (1u << b);
                const int cnt = __popcll(__ballot(k0 >= c)) + __popcll(__ballot(k1 >= c)) + __popcll(__ballot(k2 >= c)) + __popcll(__ballot(k3 >= c));
                if (cnt >= npick) T = c; } }
        const unsigned long long g0 = __ballot(k0 > T), g1 = __ballot(k1 > T), g2 = __ballot(k2 > T), g3 = __ballot(k3 > T);
        const unsigned long long e0 = __ballot(k0 == T), e1 = __ballot(k1 == T), e2 = __ballot(k2 == T), e3 = __ballot(k3 == T);
        const int need = npick - (__popcll(g0) + __popcll(g1) + __popcll(g2) + __popcll(g3));
        const unsigned long long lt_mask = (1ull << lane) - 1ull;
        const int r0 = __popcll(e0 & lt_mask), r1 = __popcll(e0) + __popcll(e1 & lt_mask), r2 = __popcll(e0) + __popcll(e1) + __popcll(e2 & lt_mask), r3 = __popcll(e0) + __popcll(e1) + __popcll(e2) + __popcll(e3 & lt_mask);
        const bool s0 = fo0 || (k0 > T) || (k0 == T && r0 < need), s1 = (fo1 && j1 <= cur) || (k1 > T) || (k1 == T && r1 < need);
        const bool s2 = (fo2 && j2 <= cur) || (k2 > T) || (k2 == T && r2 < need), s3 = (fo3 && j3 <= cur) || (k3 > T) || (k3 == T && r3 < need);
        const unsigned long long b0 = __ballot(s0), b1 = __ballot(s1), b2 = __ballot(s2), b3 = __ballot(s3);
        if (lane == 0) { LAS unsigned* sp = (LAS unsigned*)(lds + OFF_SEL + (wave * 16 + qi) * 32);
            sp[0] = (unsigned)b0; sp[1] = (unsigned)(b0 >> 32); sp[2] = (unsigned)b1; sp[3] = (unsigned)(b1 >> 32);
            sp[4] = (unsigned)b2; sp[5] = (unsigned)(b2 >> 32); sp[6] = (unsigned)b3; sp[7] = (unsigned)(b3 >> 32); }
    }
    __builtin_amdgcn_wave_barrier(); asm volatile("s_waitcnt lgkmcnt(0)" ::: "memory");
    __syncthreads();
    { LAS unsigned char* pw = lds + OFF_PART + wave * 6144 + fr * 384 + 8 * fq;
#pragma unroll
      for (int g = 0; g < 3; ++g)
#pragma unroll
        for (int dt = 0; dt < 4; ++dt) *(LAS u32x2*)(pw + g * 128 + dt * 32) = part[g][dt]; }
    const int nblk = ((t0 + 127) >> 6) + 1;
    const bf16* Ks = KVS + (size_t)b * SEQ * KVSP + kv * 64; const bf16* Vs = Ks + 128;
    const int curw = (t0 + wave * 16) >> 6;
    const bool cvalid = fr < 12; const int qq = cvalid ? fr / 3 : 0, hh = cvalid ? fr - 3 * qq : 0;
    bf16x8 q4[4][1][2]; int lo4[4][1], hi4[4][1]; AState<1> S4[4];
#pragma unroll
    for (int nb = 0; nb < 4; ++nb) { const int ql = 4 * nb + qq; lo4[nb][0] = 0; hi4[nb][0] = t0 + wave * 16 + ql; state_init<1>(S4[nb]);
        const bf16* qp = Z + ((size_t)b * SEQ + t0 + wave * 16 + ql) * ZP + ZC_QC + (kv * 3 + hh) * 64 + fq * 8; q4[nb][0][0] = *(const GAS bf16x8*)qp; q4[nb][0][1] = *(const GAS bf16x8*)(qp + 32); }
    const float cbias = cvalid ? 0.f : NEG_INF;
    KVRegs r1;
#define SEL_ISSUE(rr, j) { const size_t ro = (size_t)(64 * (j) + srow) * KVSP + sch * 8; kv_issue(rr, Ks + ro, Vs + ro); }
#define SEL_BLOCK(nb, EM, j, Kl, en) { attn_tile<1, EM, true>(S4[nb], Kl, (Kl) + TILE_B, q4[nb], 64 * (j), lo4[nb], hi4[nb], (en) ? cbias : NEG_INF, fr, fq); __builtin_amdgcn_sched_barrier(0); }
    SEL_ISSUE(r, nblk - 2) SEL_ISSUE(r1, nblk - 1)
    kv_commit(lds, 0, r, tid); kv_commit(lds, 1, r1, tid);
    __syncthreads();
    { const LAS unsigned char* Kl = lds + (curw & 1) * 2 * TILE_B;
      SEL_BLOCK(0, true, curw, Kl, true) SEL_BLOCK(1, true, curw, Kl, true) SEL_BLOCK(2, true, curw, Kl, true) SEL_BLOCK(3, true, curw, Kl, true) }
    __syncthreads();
    const int ns = nblk >> 1;
    const LAS unsigned* selw = (const LAS unsigned*)(lds + OFF_SEL + (wave * 16 + qq) * 32);
#define SEL_BITS(j, e0, e1, e2, e3) const int wi_##e0 = (j) >> 5, bi_##e0 = (j) & 31; const bool lt_##e0 = (j) < curw; \
        const bool e0 = ((selw[wi_##e0] >> bi_##e0) & 1u) && lt_##e0, e1 = ((selw[32 + wi_##e0] >> bi_##e0) & 1u) && lt_##e0, e2 = ((selw[64 + wi_##e0] >> bi_##e0) & 1u) && lt_##e0, e3 = ((selw[96 + wi_##e0] >> bi_##e0) & 1u) && lt_##e0;
#define SEL_TILE(j, slot, e0, e1, e2, e3) { const LAS unsigned char* Kl = lds + (slot) * 2 * TILE_B; \
        if (__any(e0)) SEL_BLOCK(0, false, j, Kl, e0) \
        if (__any(e1)) SEL_BLOCK(1, false, j, Kl, e1) \
        if (__any(e2)) SEL_BLOCK(2, false, j, Kl, e2) \
        if (__any(e3)) SEL_BLOCK(3, false, j, Kl, e3) }
    if (ns > 0) { SEL_ISSUE(r, 0) SEL_ISSUE(r1, 1) kv_commit(lds, 0, r, tid); kv_commit(lds, 1, r1, tid); }
    __syncthreads();
    for (int s = 0; s < ns; ++s) {
        const int sl = (s & 1) * 2;
        if (s + 1 < ns) { SEL_ISSUE(r, 2 * s + 2) SEL_ISSUE(r1, 2 * s + 3) }
        SEL_BITS(2 * s, ea0, ea1, ea2, ea3) SEL_BITS(2 * s + 1, eb0, eb1, eb2, eb3)
        SEL_TILE(2 * s, sl, ea0, ea1, ea2, ea3)
        SEL_TILE(2 * s + 1, sl + 1, eb0, eb1, eb2, eb3)
        if (s + 1 < ns) { kv_commit(lds, 2 - sl, r, tid); kv_commit(lds, 3 - sl, r1, tid); }
        __syncthreads();
    }
#undef SEL_TILE
#undef SEL_BITS
#undef SEL_BLOCK
#undef SEL_ISSUE
    float lt4[4];
#pragma unroll
    for (int nb = 0; nb < 4; ++nb) lt4[nb] = S4[nb].la[0][0];
    if (cvalid) {
#pragma unroll
        for (int nb = 0; nb < 4; ++nb) { const int ql = 4 * nb + qq; const size_t gq = (size_t)b * SEQ + t0 + wave * 16 + ql;
            const float lt = lt4[nb];
            const float sc = sigmoidf_(bf2f(Z[gq * ZP + ZC_GN + 6 + kv * 3 + hh])) / lt;
            const LAS unsigned char* pr = lds + OFF_PART + wave * 6144 + (ql * 3 + hh) * 128 + 8 * fq;
            bf16* op = BRO + gq * BRW + 768 + (kv * 3 + hh) * 64 + 4 * fq;
#pragma unroll
            for (int dt = 0; dt < 4; ++dt) *(GAS u32x2*)(op + dt * 16) = pack4(S4[nb].o[0][dt] * sc + unpack4(*(const LAS u32x2*)(pr + dt * 32))); }
    }
    __syncthreads();
}
}

constexpr int NWAVES = 8;
constexpr size_t MiB = 1u << 20;
constexpr size_t WS_CTL = 0, CTL_ZERO_BYTES = 1 * MiB;
constexpr size_t WS_B1P = 1 * MiB;
constexpr size_t WS_KC = 1 * MiB + 65536, WS_VC = WS_KC + 524288;
constexpr size_t WS_HID = 4 * MiB;
constexpr size_t WS_LSE = 6 * MiB;
constexpr size_t WS_ROUTE = 9 * MiB;
constexpr size_t WS_PB = 11 * MiB;
constexpr size_t WS_WIN = 43 * MiB, WS_WG = 56 * MiB, WS_WB = 64 * MiB, WS_WOUT = 67 * MiB, WS_PG = 69 * MiB, WS_PWW = 71 * MiB, WS_CW1 = 71 * MiB + 524288;
constexpr size_t WS_XB = 74 * MiB;
constexpr size_t WS_BR = 138 * MiB;
constexpr size_t WS_CMP = 234 * MiB;
constexpr size_t WS_Z = 251 * MiB;
constexpr size_t WS_BPROJ = WS_Z, WS_MG = WS_Z + 256 * MiB, WS_Y = WS_Z + 320 * MiB;
constexpr size_t WS_H = WS_Z, WS_FUP = WS_Z + 176 * MiB, WS_FDN = WS_Z + 188 * MiB;
constexpr size_t WS_MDN = 202 * MiB, WS_MUP = 258 * MiB, WS_XP = 370 * MiB, WS_H1 = 502 * MiB;
constexpr size_t WS_KVS = 651 * MiB;
constexpr size_t WS_END = 667 * MiB;
constexpr int XP_ROWS = 65536 + 8 * 256;
constexpr int CHUNK_TILES = 64, CHUNK_LAST = 84, NCHUNK = 5;
static_assert(WS_XP + (size_t)XP_ROWS * D * 2 <= WS_H1 && WS_H1 + (size_t)CHUNK_LAST * 256 * DFE * 2 <= WS_KVS, "moe map");
static_assert(WS_MDN + (size_t)NE * D * DFE * 2 <= WS_MUP && WS_MUP + (size_t)NE * 2 * DFE * D * 2 <= WS_XP, "moe weights map");
static_assert(WS_Z + (size_t)T * ZP * 2 <= WS_KVS && WS_KVS + (size_t)T * KVSP * 2 <= WS_END && WS_CMP + (size_t)8 * SEQ * 64 * 2 + 4096 <= WS_Z, "z map");
constexpr int CW_TMO = 0, CW_BAR = 4096, CW_CNT = 16384, CW_FILL = 20480;
constexpr int RING_BYTES = 131072, MISC_OFF = RING_BYTES + 320, LDS_BYTES = 147456;
static_assert(att::LDS_END <= RING_BYTES, "attention LDS");

#define RLX_AGENT __ATOMIC_RELAXED, __HIP_MEMORY_SCOPE_AGENT
#define XB_TMO      128
#define XB_XCNT(j)  (256  + 64 * (j))
#define XB_XSUB(j)  (1280 + 64 * (j))
#define XB_XGEN(j)  (2304 + 64 * (j))
#define XB_TOP      3328
#define XB_TOPGEN   3392
#define XCD_BAR_WORDS 3456
#define XB_SPIN_CAP (1u << 22)
__device__ __forceinline__ unsigned xb_ld(unsigned* p)              { return __hip_atomic_load(p, __ATOMIC_RELAXED, __HIP_MEMORY_SCOPE_AGENT); }
__device__ __forceinline__ unsigned xb_add(unsigned* p, unsigned v) { return __hip_atomic_fetch_add(p, v, __ATOMIC_RELAXED, __HIP_MEMORY_SCOPE_AGENT); }
__device__ __forceinline__ unsigned xb_xcc_id() { return (unsigned)__builtin_amdgcn_s_getreg((3 << 11) | 20) & 0xFu; }
#define XB_SPIN(cond, bar) do { unsigned _sp = 0; while (cond) { __builtin_amdgcn_s_sleep(1); \
    if ((++_sp & 255u) == 0u) { if (xb_ld(&(bar)[XB_TMO])) break; if (_sp > XB_SPIN_CAP) { atomicAdd(&(bar)[XB_TMO], 1u); break; } } } } while (0)
struct XcdBarrier { unsigned* bar; unsigned x; volatile LAS unsigned* st; };
__device__ __forceinline__ XcdBarrier xcd_barrier_post(unsigned* bar, volatile LAS unsigned* st) {
    XcdBarrier b; b.bar = bar; b.x = xb_xcc_id(); b.st = st;
    if (threadIdx.x == 0) (void)xb_add(&bar[XB_XCNT(b.x)], 1u);
    return b;
}
__device__ __forceinline__ void xcd_barrier_complete(unsigned* bar, unsigned x, unsigned& nloc, unsigned& nx) {
    const unsigned G = gridDim.x * gridDim.y * gridDim.z;
    unsigned sum, cnt, mine, sp = 0u;
    for (;;) {
        sum = 0u; cnt = 0u; mine = 0u;
#pragma unroll
        for (unsigned j = 0; j < 16; ++j) { const unsigned c = xb_ld(&bar[XB_XCNT(j)]); sum += c; cnt += (c > 0u) ? 1u : 0u; mine = (j == x) ? c : mine; }
        if (sum == G) break;
        __builtin_amdgcn_s_sleep(1);
        if ((++sp & 255u) == 0u) { if (xb_ld(&bar[XB_TMO])) break; if (sp > XB_SPIN_CAP) { atomicAdd(&bar[XB_TMO], 1u); break; } }
    }
    nloc = mine > 0u ? mine : 1u; nx = cnt > 0u ? cnt : 1u;
}
__device__ __forceinline__ void xcd_barrier(const XcdBarrier& b) {
    asm volatile("s_waitcnt vmcnt(0)" ::: "memory");
    __syncthreads();
    if (threadIdx.x == 0) {
        unsigned* bar = b.bar;
        __builtin_amdgcn_s_waitcnt(0);
        unsigned nloc = b.st[0], nx = b.st[1];
        if (nloc == 0u) { xcd_barrier_complete(bar, b.x, nloc, nx); b.st[0] = nloc; b.st[1] = nx; }
        const unsigned old = xb_add(&bar[XB_XSUB(b.x)], 1u);
        const unsigned gen = old / nloc;
        if (old + 1u == (gen + 1u) * nloc) {
            __builtin_amdgcn_fence(__ATOMIC_RELEASE, "agent");
            asm volatile("s_waitcnt vmcnt(0)" ::: "memory");
            const unsigned og = xb_add(&bar[XB_TOP], 1u);
            const unsigned tg = og / nx;
            if (og + 1u == (tg + 1u) * nx) xb_add(&bar[XB_TOPGEN], 1u);
            else XB_SPIN(xb_ld(&bar[XB_TOPGEN]) == tg, bar);
            __builtin_amdgcn_fence(__ATOMIC_ACQUIRE, "agent");
            xb_add(&bar[XB_XGEN(b.x)], 1u);
            asm volatile("s_waitcnt vmcnt(0)" ::: "memory");
        } else {
            XB_SPIN(xb_ld(&bar[XB_XGEN(b.x)]) == gen, bar);
            __builtin_amdgcn_fence(__ATOMIC_ACQUIRE, "agent");
            asm volatile("s_waitcnt vmcnt(0)" ::: "memory");
        }
    }
    __syncthreads();
}

template <class MapF>
__device__ __forceinline__ void conv_job(int gw, int NGW, int lane, LAS float* scr, bf16* WT, int K, int nrows, size_t ldw, const MapF& map) {
    const int nkb = K / 64, nitems = (nrows / 32) * nkb;
    for (int it = gw; it < nitems; it += NGW) {
        const int rb = it / nkb, kb = it % nkb, r0 = rb * 32, k0 = kb * 64;
        const float* src = map(r0 + (lane & 31));
#pragma unroll 8
        for (int i = 0; i < 32; ++i) { const int kk = 2 * i + (lane >> 5); scr[kk * 33 + (lane & 31)] = src ? src[(size_t)(k0 + kk) * ldw] : 0.f; }
        asm volatile("s_waitcnt lgkmcnt(0)" ::: "memory"); __builtin_amdgcn_wave_barrier();
        const int c = lane & 7;
#pragma unroll
        for (int j = 0; j < 4; ++j) { const int n = (lane >> 3) + 8 * j; const LAS float* s = scr + (8 * c) * 33 + n;
            u32x4 o; o.x = cvt_pk_bf16(s[0 * 33], s[1 * 33]); o.y = cvt_pk_bf16(s[2 * 33], s[3 * 33]); o.z = cvt_pk_bf16(s[4 * 33], s[5 * 33]); o.w = cvt_pk_bf16(s[6 * 33], s[7 * 33]);
            *(GAS u32x4*)(WT + (size_t)(r0 + n) * K + k0 + 8 * c) = o; }
        asm volatile("s_waitcnt lgkmcnt(0)" ::: "memory"); __builtin_amdgcn_wave_barrier();
    }
}
template <bool VEC, class MapF>
__device__ __forceinline__ void conv_job2(int gw, int NGW, int lane, LAS unsigned char* scrb, bf16* WT, int K, int nrows, size_t ldw, const MapF& map) {
    const int nkb = K / 64, nitems = (nrows / 64) * nkb;
    const int n4 = (lane & 15) * 4, kq = lane >> 4;
    for (int it = gw; it < nitems; it += NGW) {
        const int rb = it / nkb, kb = it % nkb, r0 = rb * 64, k0 = kb * 64;
        f32x4 v[16];
        if constexpr (VEC) { const float* src = map(r0 + n4);
#pragma unroll
            for (int i = 0; i < 16; ++i) v[i] = src ? *(const GAS f32x4*)(src + (size_t)(k0 + kq * 16 + i) * ldw) : (f32x4){0.f, 0.f, 0.f, 0.f};
        } else { const float* s0 = map(r0 + n4); const float* s1 = map(r0 + n4 + 1); const float* s2 = map(r0 + n4 + 2); const float* s3 = map(r0 + n4 + 3);
#pragma unroll
            for (int i = 0; i < 16; ++i) { const size_t o = (size_t)(k0 + kq * 16 + i) * ldw;
                v[i][0] = s0 ? ((const GAS float*)s0)[o] : 0.f; v[i][1] = s1 ? ((const GAS float*)s1)[o] : 0.f; v[i][2] = s2 ? ((const GAS float*)s2)[o] : 0.f; v[i][3] = s3 ? ((const GAS float*)s3)[o] : 0.f; } }
#pragma unroll
        for (int j = 0; j < 4; ++j)
#pragma unroll
            for (int hf = 0; hf < 2; ++hf) { const int row = n4 + j, c = kq * 2 + hf;
                const f32x4 a = {v[8 * hf + 0][j], v[8 * hf + 1][j], v[8 * hf + 2][j], v[8 * hf + 3][j]}, b = {v[8 * hf + 4][j], v[8 * hf + 5][j], v[8 * hf + 6][j], v[8 * hf + 7][j]};
                *(LAS bf16x8*)(scrb + row * 144 + ((c ^ ((row >> 2) & 7)) * 16)) = pack8(a, b); }
        asm volatile("s_waitcnt lgkmcnt(0)" ::: "memory"); __builtin_amdgcn_wave_barrier();
#pragma unroll
        for (int q = 0; q < 8; ++q) { const int row = q * 8 + (lane >> 3), c = lane & 7;
            const bf16x8 w = *(const LAS bf16x8*)(scrb + row * 144 + ((c ^ ((row >> 2) & 7)) * 16));
            *(GAS bf16x8*)(WT + (size_t)(r0 + row) * K + k0 + c * 8) = w; }
        asm volatile("s_waitcnt lgkmcnt(0)" ::: "memory"); __builtin_amdgcn_wave_barrier();
    }
}
__device__ __forceinline__ int zmap_src(int r) {
    if (r < 4992) return r;
    if (r < 5120) return 5504 + (r - 4992);
    if (r < 5248) return 5248 + (r - 5120);
    if (r < 5376) return 5376 + (r - 5248);
    if (r < 5504) return 5632 + (r - 5376);
    if (r < 5888) return 5778 + (r - 5504);
    if (r < 6016) return 6162 + (r - 5888);
    if (r < 6144) return 6290 + (r - 6016);
    if (r < 6162) return 5760 + (r - 6144);
    if (r < 6400) return -1;
    if (r < 6528) return 4992 + (r - 6400);
    return 5120 + (r - 6528);
}

struct Args { const float* in[29]; float* out; unsigned char* ws; int ph_lo, ph_hi; };

__device__ __forceinline__ void ln_store(f32x4 (&v)[4], float* xrow, bf16* brow, const float* g, const float* bb, int lane) {
    float s = 0.f;
#pragma unroll
    for (int j = 0; j < 4; ++j) s += (v[j][0] + v[j][1]) + (v[j][2] + v[j][3]);
    const float mean = wave_sum(s) * (1.f / D); float s2 = 0.f;
#pragma unroll
    for (int j = 0; j < 4; ++j) { v[j] = v[j] - mean; s2 += (v[j][0] * v[j][0] + v[j][1] * v[j][1]) + (v[j][2] * v[j][2] + v[j][3] * v[j][3]); }
    const float rstd = 1.f / sqrtf(wave_sum(s2) * (1.f / D) + LN_EPS);
#pragma unroll
    for (int j = 0; j < 4; ++j) { const f32x4 gv = *(const GAS f32x4*)(g + 256 * j + 4 * lane), bv = *(const GAS f32x4*)(bb + 256 * j + 4 * lane);
        v[j] = v[j] * rstd * gv + bv;
        if (xrow) *(GAS f32x4*)(xrow + 256 * j + 4 * lane) = v[j];
        if (brow) *(GAS u32x2*)(brow + 256 * j + 4 * lane) = pack4(v[j]); }
}

typedef __attribute__((address_space(4))) const unsigned long long kq_t;
__device__ __forceinline__ unsigned long long karg_q(int i) {
    unsigned long long p = (unsigned long long)__builtin_amdgcn_kernarg_segment_ptr(); asm volatile("" : "+s"(p));
    return *(kq_t*)(p + 8ull * i);
}
#define AIN(i) ((const float*)karg_q(i))
#define AOUT ((float*)karg_q(29))
#define LIN(i, stride) (AIN(i) + (size_t)layer * (stride))
#define P_XB   ((bf16*)(ws + WS_XB))
#define P_BR   ((bf16*)(ws + WS_BR))
#define P_Z    ((bf16*)(ws + WS_Z))
#define P_CMP  ((bf16*)(ws + WS_CMP))
#define P_KVS  ((bf16*)(ws + WS_KVS))
#define P_PB   ((bf16*)(ws + WS_PB))
#define P_KC   ((bf16*)(ws + WS_KC))
#define P_VC   ((bf16*)(ws + WS_VC))
#define P_HID  ((bf16*)(ws + WS_HID))
#define P_LSE  ((float*)(ws + WS_LSE))
#define P_B1P  ((float*)(ws + WS_B1P))
#define P_WIN  ((bf16*)(ws + WS_WIN))
#define P_WG   ((bf16*)(ws + WS_WG))
#define P_WB   ((bf16*)(ws + WS_WB))
#define P_WOUT ((bf16*)(ws + WS_WOUT))
#define P_WPG  ((bf16*)(ws + WS_PG))
#define P_WPW  ((bf16*)(ws + WS_PWW))
#define P_WC1  ((bf16*)(ws + WS_CW1))
#define P_BPROJ ((bf16*)(ws + WS_BPROJ))
#define P_MG   ((bf16*)(ws + WS_MG))
#define P_Y    ((bf16*)(ws + WS_Y))
#define P_PLE  ((bf16*)(ws + WS_BR))
#define P_H    ((bf16*)(ws + WS_H))
#define P_WFUP ((bf16*)(ws + WS_FUP))
#define P_WFDN ((bf16*)(ws + WS_FDN))
#define P_WMDN ((bf16*)(ws + WS_MDN))
#define P_WMUP ((bf16*)(ws + WS_MUP))
#define P_XP   ((bf16*)(ws + WS_XP))
#define P_H1   ((bf16*)(ws + WS_H1))
#define P_RE   ((int*)(ws + WS_ROUTE))
#define P_RPOS ((int*)(ws + WS_ROUTE) + 2 * T)
#define P_RW   ((float*)(ws + WS_ROUTE) + 4 * T)
#define P_SLOT ((int*)(ws + WS_ROUTE) + 6 * T)
#define P_ROWW ((float*)(ws + WS_ROUTE) + 8 * T)
#define P_SRC  ((int*)(ws + WS_ROUTE) + 8 * T + 69632)

__device__ __forceinline__ void load_seg(gu32* ctl, volatile LAS unsigned* MISC) {
    if (threadIdx.x == 0) { int s = 0;
        for (int e = 0; e < NE; ++e) { MISC[16 + e] = (unsigned)s; const int c = (int)__hip_atomic_load((unsigned*)ctl + CW_CNT + 64 * e, RLX_AGENT); s += (c + 255) & ~255; }
        MISC[16 + NE] = (unsigned)s; }
    __syncthreads();
}

__global__ void __launch_bounds__(NWAVES * 64, 2) mega_fwd(Args args) {
    extern __shared__ __attribute__((aligned(16))) unsigned char lds_raw[];
    LAS unsigned char* lds = (LAS unsigned char*)lds_raw;
    volatile LAS unsigned* MISC = (volatile LAS unsigned*)(lds + MISC_OFF);
    const int G = gridDim.x, bx = blockIdx.x;
    const int NGW = G * NWAVES, NGT = G * NWAVES * 64;
#define PH_IDS int tid = threadIdx.x; asm volatile("" : "+v"(tid)); const int lane = tid & 63, wave = __builtin_amdgcn_readfirstlane(tid >> 6); \
    const int gw = bx * NWAVES + wave, gtid = bx * (NWAVES * 64) + tid; LAS unsigned char* const scr = lds + wave * 16384; (void)lane; (void)gw; (void)gtid; (void)scr;
    unsigned char* const ws = (unsigned char*)karg_q(30);
    gu32* const ctl = (gu32*)(ws + WS_CTL);
    { PH_IDS for (int u = tid; u < (LDS_BYTES - RING_BYTES) / 4; u += NWAVES * 64) ((LAS unsigned*)(lds + RING_BYTES))[u] = 0u; }
    __syncthreads();
    const int lo = (int)(unsigned)karg_q(31), hi = (int)(karg_q(31) >> 32);
    XcdBarrier bar; bar.bar = (unsigned*)ctl + CW_BAR; bar.x = 0; bar.st = nullptr;
    if (hi - lo > 1) bar = xcd_barrier_post((unsigned*)ctl + CW_BAR, MISC + 8);
    int ph = 0;
#define PH_ON (ph >= lo && ph < hi)
#ifndef REP_INPROJ
#define REP_INPROJ 1
#endif
#ifndef REP_BPROJ
#define REP_BPROJ 1
#endif
#ifndef REP_GATES
#define REP_GATES 1
#endif
#ifndef REP_ATT1
#define REP_ATT1 1
#endif
#ifndef REP_ATT2
#define REP_ATT2 1
#endif
#ifndef REP_MOE
#define REP_MOE 1
#endif
#ifndef REP_MID
#define REP_MID 1
#endif
#ifndef REP_PREP
#define REP_PREP 1
#endif
#define PH_END do { if (ph >= lo && ph + 1 < hi) xcd_barrier(bar); ++ph; } while (0)

    for (int layer = 0; layer < 2; ++layer) {
        const bool moe = (layer & 1) != 0;

        if (PH_ON) for (int rep = 0; rep < REP_PREP; ++rep) { PH_IDS
            { const float* w_in = LIN(2, (size_t)D * NIN_SRC);
              conv_job2<false>(gw, NGW, lane, scr, P_WIN, D, NZ, NIN_SRC, [=](int r) -> const float* { const int s = zmap_src(r); return s >= 0 ? w_in + s : nullptr; }); }
            { const float* w_branch = LIN(10, (size_t)4 * 384 * D);
              conv_job2<true>(gw, NGW, lane, scr, P_WB, 384, 4096, D, [=](int r) -> const float* { return w_branch + (size_t)(r >> 10) * 384 * D + (r & 1023); }); }
            { const float* w_mgate = LIN(11, (size_t)4 * D * D);
              conv_job2<true>(gw, NGW, lane, scr, P_WG, D, 4096, D, [=](int r) -> const float* { const int pn = r >> 8, bj = (r >> 7) & 1, wc = (r >> 5) & 3, fq = (r >> 3) & 3, n = (r >> 2) & 1, i = r & 3;
                return w_mgate + (size_t)(2 * bj + n) * D * D + (64 * pn + 16 * wc + 4 * fq + i); }); }
            { const float* w_out = LIN(13, (size_t)D * D);
              conv_job2<true>(gw, NGW, lane, scr, P_WOUT, D, D, D, [=](int r) -> const float* { return w_out + r; }); }
            { const float* ple_gw = LIN(25, (size_t)D * D);
              conv_job2<true>(gw, NGW, lane, scr, P_WPG, D, D, D, [=](int r) -> const float* { return ple_gw + r; }); }
            { const float* ple_w = LIN(24, (size_t)PLED * D);
              conv_job2<true>(gw, NGW, lane, scr, P_WPW, PLED, D, D, [=](int r) -> const float* { return ple_w + r; }); }
            { const float* cmp_w1 = LIN(5, (size_t)2 * 2048 * 128);
              conv_job2<true>(gw, NGW, lane, scr, P_WC1, 2048, 512, 128, [=](int r) -> const float* { const int kv2 = r >> 8, n = r & 255; return n < 128 ? cmp_w1 + (size_t)kv2 * 2048 * 128 + n : nullptr; });
              const float* cmp_pos = LIN(4, 2 * 32 * 64); const float* cmp_b1 = LIN(6, 2 * 128);
              for (int o = gw; o < 256; o += NGW) { const int kv2 = o >> 7, n = o & 127; float s = 0.f;
                for (int k = lane; k < 2048; k += 64) s += cmp_pos[kv2 * 2048 + k] * cmp_w1[((size_t)kv2 * 2048 + k) * 128 + n];
                s = wave_sum(s); if (lane == 0) P_B1P[o] = s + cmp_b1[o]; } }
            if (layer == 0) {
                const float* x = AIN(0); const float* p = AIN(1); bf16* XB = P_XB; bf16* PB = P_PB;
                for (size_t i = (size_t)gtid; i < (size_t)T * D / 8; i += NGT) { const f32x4 a = *(const GAS f32x4*)(x + i * 8), b = *(const GAS f32x4*)(x + i * 8 + 4); *(GAS bf16x8*)(XB + i * 8) = pack8(a, b); }
                for (size_t i = (size_t)gtid; i < (size_t)2 * T * PLED / 8; i += NGT) { const f32x4 a = *(const GAS f32x4*)(p + i * 8), b = *(const GAS f32x4*)(p + i * 8 + 4); *(GAS bf16x8*)(PB + i * 8) = pack8(a, b); }
            }
        }
        PH_END;

        if (PH_ON) for (int rep = 0; rep < REP_INPROJ; ++rep) { PH_IDS
            pg8::SchedPlain S; S.init(T / 256, NZ / 256, G, bx); S.A = (const char*)P_XB; S.B = (const char*)P_WIN; S.at = (size_t)256 * D * 2; S.bt = (size_t)256 * D * 2;
            pg8::EpiZ E{P_Z, P_CMP, P_KVS};
            pg8::gemm_phase<pg8::EpiZ, pg8::SchedPlain, true>(lds, D, D, S, E);
        }
        PH_END;

        if (PH_ON) for (int rep = 0; rep < (layer == 0 ? REP_ATT1 : 1); ++rep) { PH_IDS
            const bool dry = rep + 1 < (layer == 0 ? REP_ATT1 : 1); bf16* const DUM = (bf16*)AOUT;
            { pg8::SchedCmp S; S.A = (const char*)P_CMP; S.B = (const char*)P_WC1; S.G = G; S.c = bx;
              pg8::EpiHid E{P_HID, P_B1P};
              pg8::gemm_phase<pg8::EpiHid, pg8::SchedCmp, false>(lds, 2048, 1024, S, E); }
            bf16* const Z = P_Z; bf16* const BR = P_BR;
            unsigned pend = 0; if (!dry && tid == 0) pend = __hip_atomic_fetch_add((unsigned*)ctl + CW_FILL + 128 + 64 * layer, 1u, RLX_AGENT);
            for (int it = 0; ; ++it) {
                int u;
                if (!dry) { if (tid == 0) { MISC[12] = pend; pend = __hip_atomic_fetch_add((unsigned*)ctl + CW_FILL + 128 + 64 * layer, 1u, RLX_AGENT); }
                    __syncthreads(); u = (int)MISC[12]; __syncthreads(); }
                else u = it * G + bx;
                if (u >= 2816) break;
                if (u < 512) {
                    const int b = u >> 8, kv = (u >> 7) & 1, tt = u & 127;
                    att::BandedArgs<3> a; a.Q = Z + ZC_QC + kv * 192; a.K = Z + ZC_KW + kv * 64; a.V = Z + ZC_VW + kv * 64; a.pitch = ZP; a.tok0 = b * SEQ; a.dil = 1; a.p0 = tt * 128; a.W = 511;
                    a.qcol_nb = 64; a.qrow_nb = 0; a.rpw = 16; a.O = (dry ? DUM : BR) + 768 + kv * 192; a.opitch = BRW; a.ocol_nb = 64; a.lse = nullptr; a.lse_stride = 0; a.sink = nullptr;
                    att::banded_unit<3>(lds, a);
                } else if (u < 2816) {
                    const int d = u - 512, g = d / 768, rr = d % 768, h = rr % 6, r2 = rr / 6, b = r2 >> 6, r3 = r2 & 63;
                    const int sh = 2 * g, dil = 1 << sh, cls = r3 & (dil - 1), pblk = r3 >> sh;
                    att::BandedArgs<2> a; a.Q = Z + ZC_QA + (g * 6 + h) * 64; a.K = Z + ZC_KA + (g * 6 + h) * 64; a.V = Z + ZC_VA + (g * 6 + h) * 64; a.pitch = ZP; a.tok0 = b * SEQ + cls; a.dil = dil;
                    a.p0 = pblk * 256; a.W = 128; a.qcol_nb = 0; a.qrow_nb = 16; a.rpw = 32; a.O = dry ? DUM + h * 64 : Z + ZC_QA + (g * 6 + h) * 64; a.opitch = dry ? BRW : ZP; a.ocol_nb = 0;
                    a.lse = P_LSE + g * 6 + h; a.lse_stride = 18; a.sink = nullptr;
                    att::banded_unit<2>(lds, a);
                }
            }
        }
        PH_END;

        if (PH_ON) for (int rep = 0; rep < REP_MID; ++rep) { PH_IDS
            const float* cmp_w2 = LIN(7, 2 * 128 * 64); const float* cmp_b2 = LIN(8, 2 * 64); const bf16* HID = P_HID;
            for (int i = tid; i < 2 * 128 * 64 / 4; i += NWAVES * 64) *(LAS f32x4*)(lds + i * 16) = *(const GAS f32x4*)(cmp_w2 + i * 4);
            __syncthreads();
            for (int row = gw; row < 2 * 4096; row += NGW) {
                const int kv2 = row >> 12, r = row & 4095;
                float s = 0.f;
                if ((r & 1023) != 1023) { s = cmp_b2[kv2 * 64 + lane]; const bf16* hp = HID + (size_t)row * 128; const LAS float* w2 = (const LAS float*)lds + kv2 * 128 * 64 + lane;
                    u32x4 hw[16];
#pragma unroll
                    for (int h8 = 0; h8 < 16; ++h8) hw[h8] = *(const GAS u32x4*)(hp + h8 * 8);
#pragma unroll
                    for (int h8 = 0; h8 < 16; ++h8) { const f32x4 a = unpack4((u32x2){hw[h8].x, hw[h8].y}), b = unpack4((u32x2){hw[h8].z, hw[h8].w});
#pragma unroll
                        for (int i = 0; i < 4; ++i) { s += a[i] * w2[(h8 * 8 + i) * 64]; s += b[i] * w2[(h8 * 8 + 4 + i) * 64]; } } }
                (kv2 ? P_VC : P_KC)[(size_t)r * 64 + lane] = (bf16)(cvt_pk_bf16(s, 0.f) & 0xffffu);
            }
            __syncthreads();
            const float* LSE = P_LSE; const bf16* Z = P_Z; bf16* BR = P_BR;
            for (int idx0 = gtid; idx0 < T * 48; idx0 += 4 * NGT) {
                float l0[4], l1[4], l2[4]; u32x4 a0[4], a1[4], a2[4];
#pragma unroll
                for (int q = 0; q < 4; ++q) { int idx = idx0 + q * NGT; idx = idx < T * 48 ? idx : idx0; const int tok = idx / 48, rem = idx % 48, h = rem >> 3, d8 = rem & 7;
                    l0[q] = LSE[(size_t)tok * 18 + h]; l1[q] = LSE[(size_t)tok * 18 + 6 + h]; l2[q] = LSE[(size_t)tok * 18 + 12 + h];
                    const bf16* zr = Z + (size_t)tok * ZP + h * 64 + d8 * 8;
                    a0[q] = *(const GAS u32x4*)zr; a1[q] = *(const GAS u32x4*)(zr + 384); a2[q] = *(const GAS u32x4*)(zr + 768); }
#pragma unroll
                for (int q = 0; q < 4; ++q) { const int idx = idx0 + q * NGT; if (idx < T * 48) { const int tok = idx / 48, rem = idx % 48, h = rem >> 3, d8 = rem & 7;
                    const float mx = fmaxf(l0[q], fmaxf(l1[q], l2[q])); float e0 = ex2((l0[q] - mx) * LOG2E), e1 = ex2((l1[q] - mx) * LOG2E), e2 = ex2((l2[q] - mx) * LOG2E); const float inv = 1.f / (e0 + e1 + e2); e0 *= inv; e1 *= inv; e2 *= inv;
                    const f32x4 r0 = unpack4((u32x2){a0[q].x, a0[q].y}) * e0 + unpack4((u32x2){a1[q].x, a1[q].y}) * e1 + unpack4((u32x2){a2[q].x, a2[q].y}) * e2;
                    const f32x4 r1 = unpack4((u32x2){a0[q].z, a0[q].w}) * e0 + unpack4((u32x2){a1[q].z, a1[q].w}) * e1 + unpack4((u32x2){a2[q].z, a2[q].w}) * e2;
                    *(GAS bf16x8*)(BR + (size_t)tok * BRW + h * 64 + d8 * 8) = pack8(r0, r1); } }
            }
        }
        PH_END;

        if (PH_ON) for (int rep = 0; rep < (layer == 0 ? REP_ATT2 : 1); ++rep) { PH_IDS
            const bool dry = rep + 1 < (layer == 0 ? REP_ATT2 : 1);
            for (int u = bx; u < 512; u += G) {
                const int uu = u & 255, bk = uu & 3, tt = (u < 256) ? (uu >> 2) : 127 - (uu >> 2), b = bk >> 1, kv = bk & 1;
                att::nsa_unit(lds, P_Z, P_KVS, P_KC + (size_t)(b * 2 + kv) * 1024 * 64, P_VC + (size_t)(b * 2 + kv) * 1024 * 64, P_BR, dry ? (bf16*)AOUT : P_BR, b, kv, tt * 128);
            }
            if (!dry) {
                bf16* const Z = P_Z; bf16* const BR = P_BR; bf16* const DUM = BR;
                for (;;) { if (tid == 0) MISC[12] = __hip_atomic_fetch_add((unsigned*)ctl + CW_FILL + 64 * layer, 1u, RLX_AGENT);
                    __syncthreads(); const int f = (int)MISC[12]; __syncthreads();
                    if (f >= 768) break;
                    const int u = f < 256 ? 3328 + f : 2816 + (f - 256);
                if (u < 3328) {
                    const int w = u - 2816, b = w >> 8, kv = (w >> 7) & 1, tt = w & 127;
                    att::BandedArgs<3> a; a.Q = Z + ZC_QD + kv * 192; a.K = Z + ZC_KD + kv * 64; a.V = Z + ZC_VD + kv * 64; a.pitch = ZP; a.tok0 = b * SEQ; a.dil = 1; a.p0 = tt * 128; a.W = 127;
                    a.qcol_nb = 64; a.qrow_nb = 0; a.rpw = 16; a.O = (dry ? DUM : BR) + 1152 + kv * 192; a.opitch = BRW; a.ocol_nb = 64; a.lse = nullptr; a.lse_stride = 0; a.sink = LIN(9, 6) + kv * 3;
                    att::banded_unit<3>(lds, a);
                } else {
                    const int cu = u - 3328; const float* conv_w = LIN(3, 3 * 384);
                    for (int it = tid; it < 128 * 48; it += NWAVES * 64) {
                        const int tl = it / 48, c8 = it % 48, tok = cu * 128 + tl, ts = tok & (SEQ - 1);
                        const bf16* zr = Z + (size_t)tok * ZP;
                        const u32x4 gbw = *(const GAS u32x4*)(zr + ZC_GB + c8 * 8);
                        f32x4 y0 = {0.f, 0.f, 0.f, 0.f}, y1 = {0.f, 0.f, 0.f, 0.f};
#pragma unroll
                        for (int k = 0; k < 3; ++k) { const int dt = 2 - k;
                            if (ts >= dt) { const bf16* zz = zr - (size_t)dt * ZP; const u32x4 gcw = *(const GAS u32x4*)(zz + ZC_GC + c8 * 8), hbw = *(const GAS u32x4*)(zz + ZC_HB + c8 * 8);
                                const f32x4 w0 = *(const GAS f32x4*)(conv_w + k * 384 + c8 * 8), w1 = *(const GAS f32x4*)(conv_w + k * 384 + c8 * 8 + 4);
                                y0 += w0 * unpack4((u32x2){gcw.x, gcw.y}) * unpack4((u32x2){hbw.x, hbw.y}); y1 += w1 * unpack4((u32x2){gcw.z, gcw.w}) * unpack4((u32x2){hbw.z, hbw.w}); } }
                        *(GAS bf16x8*)((dry ? DUM : BR) + (size_t)tok * BRW + 384 + c8 * 8) = pack8(y0 * unpack4((u32x2){gbw.x, gbw.y}), y1 * unpack4((u32x2){gbw.z, gbw.w}));
                    }
                }
                }
            }
        }
        PH_END;

        if (PH_ON) for (int rep = 0; rep < REP_BPROJ; ++rep) { PH_IDS
            pg8::SchedBproj S; S.init(T / 256, 16, G, bx); S.A = (const char*)P_BR; S.B = (const char*)P_WB; S.at = (size_t)256 * BRW * 2; S.bt = (size_t)256 * 384 * 2;
            pg8::EpiBf16 E{P_BPROJ, 4096};
            pg8::gemm_phase<pg8::EpiBf16, pg8::SchedBproj, true>(lds, 384, BRW, S, E);
        }
        PH_END;

        if (PH_ON) for (int rep = 0; rep < REP_GATES; ++rep) { PH_IDS
            pg8::SchedPlain S; S.init(T / 256, 16, G, bx); S.A = (const char*)P_XB; S.B = (const char*)P_WG; S.at = (size_t)256 * D * 2; S.bt = (size_t)256 * D * 2;
            pg8::EpiGateSum E{P_BPROJ, LIN(12, 4 * D), P_MG};
            pg8::gemm_phase<pg8::EpiGateSum, pg8::SchedPlain, true>(lds, D, D, S, E);
        }
        PH_END;

        if (PH_ON) { PH_IDS
            { pg8::SchedPlain S; S.init(T / 256, 4, G, bx); S.A = (const char*)P_MG; S.B = (const char*)P_WOUT; S.at = (size_t)256 * D * 2; S.bt = (size_t)256 * D * 2;
              pg8::EpiBf16 E{P_Y, D};
              pg8::gemm_phase<pg8::EpiBf16, pg8::SchedPlain, true>(lds, D, D, S, E); }
            if (!moe) {
              pg8::SchedPlain S; S.init(T / 256, 4, G, bx); S.A = (const char*)(P_PB + (size_t)layer * T * PLED); S.B = (const char*)P_WPW; S.at = (size_t)256 * PLED * 2; S.bt = (size_t)256 * PLED * 2;
              pg8::EpiBf16 E{P_PLE, D};
              pg8::gemm_phase<pg8::EpiBf16, pg8::SchedPlain, true>(lds, PLED, PLED, S, E); }
        }
        PH_END;

        if (PH_ON) { PH_IDS
            if (!moe) {
                const float* fg = AIN(16); const float* fu = AIN(17); const float* fd = AIN(18);
                conv_job2<true>(gw, NGW, lane, scr, P_WFUP, D, 2 * DFF, DFF, [=](int r) -> const float* { const int pn = r >> 8, half = (r >> 7) & 1, f = 128 * pn + (r & 127); return (half ? fu : fg) + f; });
                conv_job2<true>(gw, NGW, lane, scr, P_WFDN, DFF, D, D, [=](int r) -> const float* { return fd + r; });
            } else {
                const float* mg_ = AIN(21); const float* mu_ = AIN(22); const float* md_ = AIN(23);
                conv_job2<true>(gw, NGW, lane, scr, P_WMUP, D, NE * 2 * DFE, DFE, [=](int r) -> const float* { const int e = r / (2 * DFE), rr = r % (2 * DFE), pn = rr >> 8, half = (rr >> 7) & 1, f = 128 * pn + (rr & 127);
                    return (half ? mu_ : mg_) + (size_t)e * D * DFE + f; });
                conv_job2<true>(gw, NGW, lane, scr, P_WMDN, DFE, NE * D, D, [=](int r) -> const float* { return md_ + (size_t)(r >> 10) * DFE * D + (r & 1023); });
            }
            __syncthreads();
            if (moe) { const float* wr_ = AIN(19); for (int i = tid; i < D * NE; i += NWAVES * 64) ((LAS float*)lds)[i] = wr_[i];
                int* src = P_SRC;
#pragma nounroll
                for (int i = gtid; i < XP_ROWS; i += NGT) { asm volatile("" : "+v"(i)); src[i] = 0; } }
            __syncthreads();
            const float* lg_ = LIN(14, D); const float* lb_ = LIN(15, D); bf16* const XB = P_XB;
            const bf16* const Yb = P_Y;
            u32x2 xn[4], yn[4];
            if (gw < T) {
#pragma unroll
                for (int j = 0; j < 4; ++j) { xn[j] = *(const GAS u32x2*)(XB + (size_t)gw * D + 256 * j + 4 * lane); yn[j] = *(const GAS u32x2*)(Yb + (size_t)gw * D + 256 * j + 4 * lane); } }
            int pm = -1, pi1 = 0, pi2 = 0, pp1 = 0, pp2 = 0; float pw1 = 0.f, pw2 = 0.f;
            for (int m = gw; m < T; m += NGW) {
                f32x4 v[4];
#pragma unroll
                for (int j = 0; j < 4; ++j) v[j] = unpack4(xn[j]) * ALPHA + unpack4(yn[j]);
                if (m + NGW < T) {
#pragma unroll
                    for (int j = 0; j < 4; ++j) { xn[j] = *(const GAS u32x2*)(XB + (size_t)(m + NGW) * D + 256 * j + 4 * lane); yn[j] = *(const GAS u32x2*)(Yb + (size_t)(m + NGW) * D + 256 * j + 4 * lane); } }
                ln_store(v, nullptr, XB + (size_t)m * D, lg_, lb_, lane);
                if (moe) {
                    float l0 = 0.f, l1 = 0.f, l2 = 0.f, l3 = 0.f, l4 = 0.f, l5 = 0.f, l6 = 0.f, l7 = 0.f;
#pragma unroll
                    for (int j = 0; j < 4; ++j)
#pragma unroll
                        for (int i = 0; i < 4; ++i) { const LAS float* wp = (const LAS float*)lds + (256 * j + 4 * lane + i) * NE; const f32x4 w0 = *(const LAS f32x4*)wp, w1 = *(const LAS f32x4*)(wp + 4);
                            l0 += v[j][i] * w0[0]; l1 += v[j][i] * w0[1]; l2 += v[j][i] * w0[2]; l3 += v[j][i] * w0[3];
                            l4 += v[j][i] * w1[0]; l5 += v[j][i] * w1[1]; l6 += v[j][i] * w1[2]; l7 += v[j][i] * w1[3]; }
                    const float* br_ = AIN(20);
                    l0 = wave_sum(l0) + br_[0]; l1 = wave_sum(l1) + br_[1]; l2 = wave_sum(l2) + br_[2]; l3 = wave_sum(l3) + br_[3];
                    l4 = wave_sum(l4) + br_[4]; l5 = wave_sum(l5) + br_[5]; l6 = wave_sum(l6) + br_[6]; l7 = wave_sum(l7) + br_[7];
                    int i1 = 0; float v1 = l0;
                    if (l1 > v1) { v1 = l1; i1 = 1; } if (l2 > v1) { v1 = l2; i1 = 2; } if (l3 > v1) { v1 = l3; i1 = 3; } if (l4 > v1) { v1 = l4; i1 = 4; }
                    if (l5 > v1) { v1 = l5; i1 = 5; } if (l6 > v1) { v1 = l6; i1 = 6; } if (l7 > v1) { v1 = l7; i1 = 7; }
                    int i2 = -1; float v2 = -__builtin_inff();
                    if (i1 != 0 && l0 > v2) { v2 = l0; i2 = 0; } if (i1 != 1 && l1 > v2) { v2 = l1; i2 = 1; } if (i1 != 2 && l2 > v2) { v2 = l2; i2 = 2; } if (i1 != 3 && l3 > v2) { v2 = l3; i2 = 3; }
                    if (i1 != 4 && l4 > v2) { v2 = l4; i2 = 4; } if (i1 != 5 && l5 > v2) { v2 = l5; i2 = 5; } if (i1 != 6 && l6 > v2) { v2 = l6; i2 = 6; } if (i1 != 7 && l7 > v2) { v2 = l7; i2 = 7; }
                    const float w1 = 1.f / (1.f + __expf(v2 - v1)), w2 = 1.f - w1;
                    if (lane == 0) {
                        int* re = P_RE; int* rp = P_RPOS; float* rw = P_RW;
                        if (pm >= 0) { re[2 * pm] = pi1; re[2 * pm + 1] = pi2; rp[2 * pm] = pp1; rp[2 * pm + 1] = pp2; rw[2 * pm] = pw1; rw[2 * pm + 1] = pw2; }
                        pp1 = (int)__hip_atomic_fetch_add((unsigned*)ctl + CW_CNT + 64 * i1, 1u, RLX_AGENT); pp2 = (int)__hip_atomic_fetch_add((unsigned*)ctl + CW_CNT + 64 * i2, 1u, RLX_AGENT);
                    }
                    pm = m; pi1 = i1; pi2 = i2; pw1 = w1; pw2 = w2;
                }
            }
            if (moe && lane == 0 && pm >= 0) { int* re = P_RE; int* rp = P_RPOS; float* rw = P_RW; re[2 * pm] = pi1; re[2 * pm + 1] = pi2; rp[2 * pm] = pp1; rp[2 * pm + 1] = pp2; rw[2 * pm] = pw1; rw[2 * pm + 1] = pw2; }
        }
        PH_END;

        if (!moe) {
            if (PH_ON) { PH_IDS
                pg8::SchedUp0 S; S.init(T / 256, 26, G, bx); S.A = (const char*)P_XB; S.B = (const char*)P_WFUP; S.B2 = (const char*)P_WPG; S.at = (size_t)256 * D * 2; S.bt = (size_t)256 * D * 2; S.nup = 22;
                pg8::EpiUp E{P_H, DFF, 22, 0, LIN(26, D), P_PLE};
                pg8::gemm_phase<pg8::EpiUp, pg8::SchedUp0, true>(lds, D, D, S, E);
            }
            PH_END;
            if (PH_ON) { PH_IDS
                pg8::SchedPlain S; S.init(T / 256, 4, G, bx); S.A = (const char*)P_H; S.B = (const char*)P_WFDN; S.at = (size_t)256 * DFF * 2; S.bt = (size_t)256 * DFF * 2;
                pg8::EpiDown E{P_XB, P_PLE};
                pg8::gemm_phase<pg8::EpiDown, pg8::SchedPlain, true>(lds, DFF, DFF, S, E);
            }
            PH_END;
        } else {
            const LAS int* segl = (const LAS int*)(lds + MISC_OFF + 64);
            if (PH_ON) { PH_IDS
                load_seg(ctl, MISC);
                const int* re = P_RE; const int* rp = P_RPOS; const float* rw = P_RW; int* slot = P_SLOT; float* roww = P_ROWW; int* src = P_SRC;
#pragma nounroll
                for (int it = gtid; it < 2 * T; it += NGT) { asm volatile("" : "+v"(it)); const int row = segl[re[it]] + rp[it]; slot[it] = row; roww[row] = rw[it]; src[row] = it >> 1; }
            }
            PH_END;
            for (int ch = 0; ch < NCHUNK; ++ch) {
                const int tile0 = ch < 4 ? ch * CHUNK_TILES : 3 * CHUNK_TILES + CHUNK_LAST, cap = ch == 3 ? CHUNK_LAST : CHUNK_TILES;
                if (hi - lo > 1 && ch >= 4 && (__builtin_amdgcn_readfirstlane(segl[NE]) >> 8) <= tile0) break;
                if (PH_ON) for (int rep = 0; rep < REP_MOE; ++rep) { PH_IDS
                    load_seg(ctl, MISC);
                    int ntile = (__builtin_amdgcn_readfirstlane(segl[NE]) >> 8) - tile0; ntile = ntile < 0 ? 0 : (ntile > cap ? cap : ntile);
                    pg8::SchedMoeG S; S.A = (const char*)P_XB; S.B = (const char*)P_WMUP; S.at = (size_t)256 * D * 2; S.bt_tile = (size_t)256 * D * 2; S.bt_exp = (size_t)2 * DFE * D * 2;
                    S.G = G; S.c = bx; S.nN = 28; S.tile0 = tile0; S.ntile = ntile; S.seg = segl; S.lidx = (const LAS int*)(lds + MISC_OFF + 2048);
                    { const int* src = P_SRC; int vals[6];
#pragma unroll
                      for (int j = 0; j < 6; ++j) { pg8::Unit uu; const bool ok = S.next((tid >> 8) + 2 * j, uu); vals[j] = ok ? src[uu.pm * 256 + (tid & 255)] : 0; }
#pragma unroll
                      for (int j = 0; j < 6; ++j) ((LAS int*)(lds + MISC_OFF + 2048))[((tid >> 8) + 2 * j) * 256 + (tid & 255)] = vals[j];
                      __syncthreads(); }
                    pg8::EpiUp E{P_H1, DFE, 28, tile0 * 256, nullptr, nullptr};
                    pg8::gemm_phase<pg8::EpiUp, pg8::SchedMoeG, true, true>(lds, D, D, S, E);
                }
                PH_END;
                if (PH_ON) for (int rep = 0; rep < REP_MOE; ++rep) { PH_IDS
                    load_seg(ctl, MISC);
                    int ntile = (__builtin_amdgcn_readfirstlane(segl[NE]) >> 8) - tile0; ntile = ntile < 0 ? 0 : (ntile > cap ? cap : ntile);
                    pg8::SchedMoe S; S.A = (const char*)P_H1; S.B = (const char*)P_WMDN; S.at = (size_t)256 * DFE * 2; S.bt_tile = (size_t)256 * DFE * 2; S.bt_exp = (size_t)D * DFE * 2;
                    S.G = G; S.c = bx; S.nN = 4; S.tile0 = tile0; S.ntile = ntile; S.seg = segl;
                    pg8::EpiMoeDown E{P_XP, P_ROWW};
                    pg8::gemm_phase<pg8::EpiMoeDown, pg8::SchedMoe, true>(lds, DFE, DFE, S, E);
                    if (ch == 3) {
                        const int skip = G >= 64 ? 32 : 0;
                        if (bx >= skip) {
                            { pg8::SchedPlain S1; S1.init(T / 256, 4, G - skip, bx - skip); S1.A = (const char*)(P_PB + (size_t)layer * T * PLED); S1.B = (const char*)P_WPW; S1.at = (size_t)256 * PLED * 2; S1.bt = (size_t)256 * PLED * 2;
                              pg8::EpiBf16 E1{P_PLE, D};
                              pg8::gemm_phase<pg8::EpiBf16, pg8::SchedPlain, true>(lds, PLED, PLED, S1, E1); }
                            pg8::SchedPlain S2; S2.init(T / 256, 4, G - skip, bx - skip); S2.A = (const char*)P_XB; S2.B = (const char*)P_WPG; S2.at = (size_t)256 * D * 2; S2.bt = (size_t)256 * D * 2;
                            pg8::EpiUp E2{nullptr, 0, 0, 0, LIN(26, D), P_PLE};
                            pg8::gemm_phase<pg8::EpiUp, pg8::SchedPlain, true>(lds, D, D, S2, E2); }
                    }
                }
                PH_END;
            }
        }

        if (PH_ON) { PH_IDS
            const float* lg_ = LIN(27, D); const float* lb_ = LIN(28, D); float* const xres = AOUT; bf16* const XB = P_XB; const bf16* XP = P_XP; const bf16* PL = P_PLE; const int* slot = P_SLOT;
            for (int m = gw; m < T; m += NGW) {
                float* xr = xres + (size_t)m * D; bf16* xb = XB + (size_t)m * D; f32x4 v[4];
#pragma unroll
                for (int j = 0; j < 4; ++j) v[j] = unpack4(*(const GAS u32x2*)(xb + 256 * j + 4 * lane));
                if (moe) { const int s0 = slot[2 * m], s1 = slot[2 * m + 1];
#pragma unroll
                    for (int j = 0; j < 4; ++j) { const int c = 256 * j + 4 * lane;
                        v[j] = v[j] * ALPHA + unpack4(*(const GAS u32x2*)(XP + (size_t)s0 * D + c)) + unpack4(*(const GAS u32x2*)(XP + (size_t)s1 * D + c)) + unpack4(*(const GAS u32x2*)(PL + (size_t)m * D + c)); } }
                ln_store(v, layer == 0 ? nullptr : xr, layer == 0 ? xb : nullptr, lg_, lb_, lane);
            }
        }
        PH_END;
    }
#undef PH_ON
#undef PH_END
}

#ifndef MK_PER_PHASE
#define MK_PER_PHASE 0
#endif
constexpr int N_PHASES = 12 + 21;
extern "C" void kernel_launch(void* const* d_in, const int* in_sizes, int n_in, void* d_out, int out_size, void* d_ws, size_t ws_size, hipStream_t stream) {
    static int grid = 0;
    if (grid == 0) {
        if (n_in != 29 || out_size != T * D || ws_size < WS_END) { fprintf(stderr, "kernel_launch: unexpected problem (n_in %d, out %d, ws %zu < %zu); nothing launched\n", n_in, out_size, ws_size, (size_t)WS_END); grid = -1; return; }
        int dev = 0, cus = 0, per_cu = 0;
        if (hipGetDevice(&dev) != hipSuccess || hipDeviceGetAttribute(&cus, hipDeviceAttributeMultiprocessorCount, dev) != hipSuccess) { grid = -1; return; }
        if (hipFuncSetAttribute((const void*)mega_fwd, hipFuncAttributeMaxDynamicSharedMemorySize, LDS_BYTES) != hipSuccess) { fprintf(stderr, "kernel_launch: hipFuncSetAttribute failed\n"); grid = -1; return; }
        if (hipOccupancyMaxActiveBlocksPerMultiprocessor(&per_cu, (const void*)mega_fwd, NWAVES * 64, LDS_BYTES) != hipSuccess || per_cu < 1) { fprintf(stderr, "kernel_launch: occupancy query says %d blocks per CU\n", per_cu); (void)hipGetLastError(); grid = -1; return; }
        grid = cus;
    }
    if (grid < 0) return;
    if (hipMemsetAsync((char*)d_ws + WS_CTL, 0, CTL_ZERO_BYTES, stream) != hipSuccess) return;
    Args a{};
    for (int i = 0; i < 29; ++i) a.in[i] = (const float*)d_in[i];
    a.out = (float*)d_out; a.ws = (unsigned char*)d_ws;
#if MK_PER_PHASE
    for (int p = 0; p < N_PHASES; ++p) { a.ph_lo = p; a.ph_hi = p + 1; hipLaunchKernelGGL(mega_fwd, dim3(grid), dim3(NWAVES * 64), LDS_BYTES, stream, a); }
#else
    a.ph_lo = 0; a.ph_hi = 1 << 20;
    hipLaunchKernelGGL(mega_fwd, dim3(grid), dim3(NWAVES * 64), LDS_BYTES, stream, a);
#endif
}
```

```cpp
#include <hip/hip_runtime.h>
#include <cstdio>
#include <cstdint>

#define GAS __attribute__((address_space(1)))
#define LAS __attribute__((address_space(3)))
typedef unsigned short bf16;
typedef short bf16x8 __attribute__((ext_vector_type(8)));
typedef short s16x4 __attribute__((ext_vector_type(4)));
typedef float f32x4 __attribute__((ext_vector_type(4)));
typedef unsigned u32x4 __attribute__((ext_vector_type(4)));
typedef unsigned u32x2 __attribute__((ext_vector_type(2)));
typedef GAS unsigned gu32;

constexpr int BATCH = 2, SEQ = 16384, T = BATCH * SEQ, D = 1024;
constexpr int NIN_SRC = 6418;
constexpr int ZP = 6400;
constexpr int NZ = 6656;
constexpr int BRW = 1536;
constexpr int DFF = 2816, NE = 8, DFE = 3584, PLED = 256;
constexpr float LN_EPS = 1e-5f;
constexpr float ALPHA = 1.4142135623730951f;
constexpr float LOG2E = 1.4426950408889634f, LN2 = 0.6931471805599453f;
constexpr int ZC_QA = 0, ZC_KA = 1152, ZC_VA = 2304, ZC_GB = 3456, ZC_GC = 3840, ZC_HB = 4224, ZC_QC = 4608, ZC_KW = 4992,
              ZC_VW = 5376, ZC_QD = 5504, ZC_KD = 5888, ZC_VD = 6016, ZC_GN = 6144;
constexpr int KVSP = 256;

__device__ __forceinline__ float bf2f(unsigned h) { return __builtin_bit_cast(float, h << 16); }
typedef float f32x2_t __attribute__((ext_vector_type(2)));
typedef __bf16 bf16x2_t __attribute__((ext_vector_type(2)));
__device__ __forceinline__ unsigned cvt_pk_bf16(float lo, float hi) { f32x2_t v = {lo, hi}; bf16x2_t b = __builtin_convertvector(v, bf16x2_t); return __builtin_bit_cast(unsigned, b); }
__device__ __forceinline__ float ex2(float x) { return __builtin_amdgcn_exp2f(x); }
__device__ __forceinline__ float rcpf(float x) { return __builtin_amdgcn_rcpf(x); }
__device__ __forceinline__ float sigmoidf_(float x) { return rcpf(1.f + ex2(-x * LOG2E)); }
__device__ __forceinline__ float siluf_(float x) { return x * sigmoidf_(x); }
__device__ __forceinline__ float gelu_tanh(float x) { const float y = 0.7978845608028654f * (x + 0.044715f * x * x * x); const float e = ex2(2.f * LOG2E * y); const float t = 1.f - 2.f * rcpf(1.f + e); return 0.5f * x * (1.f + t); }
__device__ __forceinline__ f32x4 unpack4(u32x2 w) { f32x4 r; r[0] = bf2f(w.x & 0xffffu); r[1] = bf2f(w.x >> 16); r[2] = bf2f(w.y & 0xffffu); r[3] = bf2f(w.y >> 16); return r; }
__device__ __forceinline__ u32x2 pack4(f32x4 v) { u32x2 w; w.x = cvt_pk_bf16(v[0], v[1]); w.y = cvt_pk_bf16(v[2], v[3]); return w; }
__device__ __forceinline__ bf16x8 pack8(f32x4 a, f32x4 b) { u32x4 w; w.x = cvt_pk_bf16(a[0], a[1]); w.y = cvt_pk_bf16(a[2], a[3]); w.z = cvt_pk_bf16(b[0], b[1]); w.w = cvt_pk_bf16(b[2], b[3]); return __builtin_bit_cast(bf16x8, w); }
__device__ __forceinline__ unsigned cvt4_fp8(float a, float b, float c, float d) {
    a = __builtin_amdgcn_fmed3f(a, -448.f, 448.f); b = __builtin_amdgcn_fmed3f(b, -448.f, 448.f); c = __builtin_amdgcn_fmed3f(c, -448.f, 448.f); d = __builtin_amdgcn_fmed3f(d, -448.f, 448.f);
    unsigned w = 0u; w = (unsigned)__builtin_amdgcn_cvt_pk_fp8_f32(a, b, (int)w, false); w = (unsigned)__builtin_amdgcn_cvt_pk_fp8_f32(c, d, (int)w, true); return w; }
constexpr float F8_SX = 8.f, F8_SG = 256.f, F8_SU = 512.f, F8_SH = 16.f, F8_SD = 1024.f;
__device__ __forceinline__ float wave_sum(float v) {
#pragma unroll
    for (int o = 1; o < 64; o <<= 1) v += __shfl_xor(v, o);
    return v;
}

__device__ __forceinline__ float quad_max(float m) {
    auto r = __builtin_amdgcn_permlane16_swap(__float_as_uint(m), __float_as_uint(m), false, false); m = fmaxf(__uint_as_float(r[0]), __uint_as_float(r[1]));
    auto q = __builtin_amdgcn_permlane32_swap(__float_as_uint(m), __float_as_uint(m), false, false); return fmaxf(__uint_as_float(q[0]), __uint_as_float(q[1]));
}
__device__ __forceinline__ float quad_sum(float m) {
    auto r = __builtin_amdgcn_permlane16_swap(__float_as_uint(m), __float_as_uint(m), false, false); m = __uint_as_float(r[0]) + __uint_as_float(r[1]);
    auto q = __builtin_amdgcn_permlane32_swap(__float_as_uint(m), __float_as_uint(m), false, false); return __uint_as_float(q[0]) + __uint_as_float(q[1]);
}

namespace pg8 {
constexpr int BM = 256, BK = 64, HALF = 128, HTB = HALF * BK * 2, STAGE_BYTES = 8 * HTB, NXCD = 8, WGM = 8;
__host__ __device__ __forceinline__ int lds_byte(int r, int c) { const int st = (r >> 4) * 2 + (c >> 5), rr = r & 15, cc = c & 31, ob = rr * 64 + cc * 2; return st * 1024 + (ob ^ (((ob >> 9) & 1) << 5)); }
__host__ __device__ __forceinline__ void stage_rc(int b, int& R, int& C) { const int st = b / 1024, sb = b % 1024, swz = sb ^ (((sb >> 9) & 1) << 5); R = (st >> 1) * 16 + swz / 64; C = (st & 1) * 32 + (swz % 64) / 2; }
__host__ __device__ __forceinline__ int perm32(int rho) { const int n = rho >> 4, i = rho & 15; return 8 * (i >> 2) + 4 * n + (i & 3); }

struct Unit { int pm, pn; };

struct StaticOrder {
    int nM, nN, nwg, G, c;
    __device__ __forceinline__ void init(int nM_, int nN_, int G_, int c_) { nM = nM_; nN = nN_; nwg = nM * nN; G = G_; c = c_; }
    __device__ __forceinline__ bool next(int i, Unit& u) const {
        const long L = (long)i * G + c; if (L >= nwg) return false;
        int wgid = (int)L; { const int q = nwg / NXCD, r = nwg % NXCD, xcd = wgid % NXCD, off = wgid / NXCD; wgid = (xcd < r ? xcd * (q + 1) : r * (q + 1) + (xcd - r) * q) + off; }
        const int nig = WGM * nN, gid = wgid / nig, fm = gid * WGM, gsz = (nM - fm) < WGM ? (nM - fm) : WGM;
        u.pm = fm + ((wgid % nig) % gsz); u.pn = (wgid % nig) / gsz; return true;
    }
};

typedef int i32x8 __attribute__((ext_vector_type(8)));
__device__ __forceinline__ i32x8 cat8(bf16x8 a, bf16x8 b) { const u32x4 x = __builtin_bit_cast(u32x4, a), y = __builtin_bit_cast(u32x4, b); return (i32x8){(int)x.x, (int)x.y, (int)x.z, (int)x.w, (int)y.x, (int)y.y, (int)y.z, (int)y.w}; }
template <class Epi, class Sched, bool ALIGN_EPI, bool GATH = false, bool F8 = false>
__device__ __forceinline__ void gemm_phase(LAS unsigned char* lds, const int K, const size_t lda, const Sched& S, const Epi& E) {
    int tid = threadIdx.x; asm volatile("" : "+v"(tid));
    const int wid = __builtin_amdgcn_readfirstlane(tid >> 6), lane = tid & 63, wr = wid >> 2, wc = wid & 3, fr = lane & 15, fq = lane >> 4;
    const int nt = K / BK;
    unsigned voffA[2], voffB[2];
#pragma unroll
    for (int i = 0; i < 2; ++i) { int R, C; stage_rc(tid * 16 + i * 8192, R, C); const int Rb = (R & ~31) + perm32(R & 31);
        voffA[i] = GATH ? (unsigned)(R * 4 + C * 2 * 65536) : (unsigned)((size_t)R * lda + C) * 2u; voffB[i] = (unsigned)(Rb * K + C) * 2u; }
    unsigned gv[2][2];
#define PG8_GLOAD(g, ord) do { _Pragma("unroll") for (int _h = 0; _h < 2; ++_h) _Pragma("unroll") for (int _i = 0; _i < 2; ++_i) \
        g[_h][_i] = (unsigned)(*(const LAS int*)((const LAS char*)S.lidx + (ord) * 1024 + _h * 512 + (voffA[_i] & 0xffffu))) * (unsigned)(lda * 2) + (voffA[_i] >> 16); } while (0)
    const size_t kstep = (size_t)(BK * 2);
    const size_t hstA = (size_t)HALF * lda * 2, hstB = (size_t)HALF * K * 2;
    const unsigned ldsw = (unsigned)wid * 1024u;
    const int aoff = lds_byte(wr * 64 + fr, fq * 8), boff = lds_byte(wc * 32 + fr, fq * 8);
#define PG8_SA(b, h) (((b) * 2 + (h)) * HTB)
#define PG8_SB(b, h) ((4 + (b) * 2 + (h)) * HTB)
#define PG8_STAGE(bufoff, gbase, voff) do { _Pragma("unroll") for (int _i = 0; _i < 2; ++_i) \
        __builtin_amdgcn_global_load_lds((const unsigned*)((const char*)(gbase) + (voff)[_i]), (LAS unsigned*)(lds + (bufoff) + ldsw + _i * 8192), 16, 0, 0); } while (0)
#define PG8_STAGE_A(bufoff, gbase, h, nx) do { if constexpr (GATH) { _Pragma("unroll") for (int _i = 0; _i < 2; ++_i) { \
        __builtin_amdgcn_global_load_lds((const unsigned*)((const char*)(gbase) + gv[h][_i]), (LAS unsigned*)(lds + (bufoff) + ldsw + _i * 8192), 16, 0, 0); } } \
    else { PG8_STAGE(bufoff, (gbase) + (h) * hstA, voffA); } } while (0)
#define PG8_LDA(dst, b, h) do { _Pragma("unroll") for (int m = 0; m < 4; ++m) _Pragma("unroll") for (int k = 0; k < 2; ++k) dst[m][k] = *(const LAS bf16x8*)(lds + PG8_SA(b, h) + aoff + m * 2048 + k * 1024); } while (0)
#define PG8_LDB(dst, b, h) do { _Pragma("unroll") for (int n = 0; n < 2; ++n) _Pragma("unroll") for (int k = 0; k < 2; ++k) dst[n][k] = *(const LAS bf16x8*)(lds + PG8_SB(b, h) + boff + n * 2048 + k * 1024); } while (0)
#define PG8_MMA(ai, bj, At, Bt) do { __builtin_amdgcn_s_setprio(1); if constexpr (F8) { _Pragma("unroll") for (int m = 0; m < 4; ++m) _Pragma("unroll") for (int n = 0; n < 2; ++n) \
        asm volatile("v_mfma_f32_16x16x128_f8f6f4 %0, %1, %2, %0" : "+v"(acc[ai][bj][m][n]) : "v"(cat8(Bt[n][0], Bt[n][1])), "v"(cat8(At[m][0], At[m][1]))); } else { \
        _Pragma("unroll") for (int m = 0; m < 4; ++m) _Pragma("unroll") for (int n = 0; n < 2; ++n) _Pragma("unroll") for (int k = 0; k < 2; ++k) \
        acc[ai][bj][m][n] = __builtin_amdgcn_mfma_f32_16x16x32_bf16(Bt[n][k], At[m][k], acc[ai][bj][m][n], 0, 0, 0); } __builtin_amdgcn_s_setprio(0); } while (0)
#define PG8_WAIT_V(n) asm volatile("s_waitcnt vmcnt(" #n ")" ::: "memory")
#define PG8_WAIT_L(n) asm volatile("s_waitcnt lgkmcnt(" #n ")" ::: "memory")
#define PG8_BAR __builtin_amdgcn_s_barrier()
#define PG8_SCHED __builtin_amdgcn_sched_barrier(0)
    Unit cur, nxt; int ui = 0;
    if (!S.next(0, cur)) return;
    f32x4 acc[2][2][4][2];
#pragma unroll
    for (int a = 0; a < 2; ++a)
#pragma unroll
        for (int b = 0; b < 2; ++b)
#pragma unroll
            for (int m = 0; m < 4; ++m)
#pragma unroll
                for (int n = 0; n < 2; ++n) acc[a][b][m][n] = (f32x4){0.f, 0.f, 0.f, 0.f};
    bf16x8 At[4][2], B0[2][2], B1[2][2];
    const char* cA = S.aptr(cur); const char* cB = S.bptr(cur);
    if constexpr (GATH) { PG8_GLOAD(gv, 0); }
    PG8_STAGE(PG8_SB(0, 0), cB, voffB); PG8_STAGE(PG8_SB(0, 1), cB + hstB, voffB); PG8_STAGE_A(PG8_SA(0, 0), cA, 0, false); PG8_STAGE_A(PG8_SA(0, 1), cA, 1, false);
    if (wr == 1) PG8_BAR;
    PG8_WAIT_V(2); PG8_BAR;
    PG8_STAGE(PG8_SB(1, 0), cB + kstep, voffB); PG8_STAGE_A(PG8_SA(1, 0), cA + kstep, 0, false); PG8_STAGE(PG8_SB(1, 1), cB + hstB + kstep, voffB);
    PG8_WAIT_V(6); PG8_BAR;
    for (;;) {
        const bool has_next = S.next(ui + 1, nxt);
        const char* nA = has_next ? S.aptr(nxt) : cA; const char* nB = has_next ? S.bptr(nxt) : cB;
#pragma nounroll
        for (int t = 0; t < nt; t += 2) {
            const bool last = (t == nt - 2);
            const char* a1 = cA + (size_t)(t + 1) * kstep;
            const char* a2 = last ? nA : cA + (size_t)(t + 2) * kstep; const char* b2 = last ? nB : cB + (size_t)(t + 2) * kstep;
            const char* a3 = a2 + kstep; const char* b3 = b2 + kstep;
            PG8_LDB(B0, 0, 0); PG8_LDB(B1, 0, 1); PG8_SCHED; PG8_LDA(At, 0, 0); PG8_STAGE_A(PG8_SA(1, 1), a1, 1, false); if constexpr (GATH) { if (last) { PG8_GLOAD(gv, has_next ? ui + 1 : ui); } }
            PG8_WAIT_V(8); PG8_WAIT_L(0); PG8_BAR; PG8_MMA(0, 0, At, B0); PG8_MMA(0, 1, At, B1); PG8_BAR; PG8_SCHED;
            PG8_LDA(At, 0, 1); PG8_STAGE(PG8_SB(0, 0), b2, voffB); PG8_STAGE(PG8_SB(0, 1), b2 + hstB, voffB); PG8_STAGE_A(PG8_SA(0, 0), a2, 0, last);
            PG8_WAIT_V(8); PG8_WAIT_L(0); PG8_BAR; PG8_MMA(1, 0, At, B0); PG8_MMA(1, 1, At, B1); PG8_BAR; PG8_SCHED;
            PG8_LDB(B0, 1, 0); PG8_LDB(B1, 1, 1); PG8_SCHED; PG8_LDA(At, 1, 0); PG8_STAGE_A(PG8_SA(0, 1), a2, 1, last);
            PG8_WAIT_V(8); PG8_WAIT_L(0); PG8_BAR; PG8_MMA(0, 0, At, B0); PG8_MMA(0, 1, At, B1); PG8_BAR; PG8_SCHED;
            PG8_LDA(At, 1, 1); PG8_STAGE(PG8_SB(1, 0), b3, voffB); PG8_STAGE(PG8_SB(1, 1), b3 + hstB, voffB); PG8_STAGE_A(PG8_SA(1, 0), a3, 0, last);
            PG8_WAIT_V(8); PG8_WAIT_L(0); PG8_BAR; PG8_MMA(1, 0, At, B0); PG8_MMA(1, 1, At, B1); PG8_BAR; PG8_SCHED;
        }
        if constexpr (ALIGN_EPI) { if (wr == 0) PG8_BAR; }
        if constexpr (F8) asm volatile("s_nop 15\n\ts_nop 15\n\ts_nop 15" ::: "memory");
        PG8_SCHED; { int fr2 = fr, fq2 = fq; asm volatile("" : "+v"(fr2), "+v"(fq2)); E(acc, cur, wr, wc, fr2, fq2); } PG8_SCHED;
        if (!has_next) break;
#pragma unroll
        for (int a = 0; a < 2; ++a)
#pragma unroll
            for (int b = 0; b < 2; ++b)
#pragma unroll
                for (int m = 0; m < 4; ++m)
#pragma unroll
                    for (int n = 0; n < 2; ++n) acc[a][b][m][n] = (f32x4){0.f, 0.f, 0.f, 0.f};
        cur = nxt; cA = nA; cB = nB; ++ui;
        if constexpr (ALIGN_EPI) { if (wr == 1) PG8_BAR; }
    }
    PG8_WAIT_V(0);
    if constexpr (!ALIGN_EPI) { if (wr == 0) PG8_BAR; }
    PG8_BAR;
#undef PG8_SA
#undef PG8_SB
#undef PG8_STAGE
#undef PG8_STAGE_A
#undef PG8_GLOAD
#undef PG8_LDA
#undef PG8_LDB
#undef PG8_MMA
#undef PG8_WAIT_V
#undef PG8_WAIT_L
#undef PG8_BAR
#undef PG8_SCHED
}

struct SchedPlain : StaticOrder {
    const char* A; const char* B; size_t at, bt;
    __device__ __forceinline__ const char* aptr(const Unit& u) const { return A + (size_t)u.pm * at; }
    __device__ __forceinline__ const char* bptr(const Unit& u) const { return B + (size_t)u.pn * bt; }
};
struct SchedBproj : StaticOrder {
    const char* A; const char* B; size_t at, bt;
    __device__ __forceinline__ const char* aptr(const Unit& u) const { return A + (size_t)u.pm * at + (size_t)(u.pn >> 2) * 384 * 2; }
    __device__ __forceinline__ const char* bptr(const Unit& u) const { return B + (size_t)u.pn * bt; }
};
struct SchedUp0 : StaticOrder {
    const char* A; const char* B; const char* B2; size_t at, bt; int nup;
    __device__ __forceinline__ const char* aptr(const Unit& u) const { return A + (size_t)u.pm * at; }
    __device__ __forceinline__ const char* bptr(const Unit& u) const { return u.pn < nup ? B + (size_t)u.pn * bt : B2 + (size_t)(u.pn - nup) * bt; }
};
struct SchedCmp {
    const char* A; const char* B; int G, c;
    __device__ __forceinline__ bool next(int i, Unit& u) const { const int L = i * G + c; if (L >= 32) return false; u.pm = L; u.pn = 0; return true; }
    __device__ __forceinline__ const char* aptr(const Unit& u) const { const int L = u.pm, kv2 = L >> 4, seg = (L >> 2) & 3, mt = L & 3, b = seg >> 1, kv = seg & 1;
        return A + ((size_t)((b * 4 + kv2 * 2 + kv)) * SEQ * 64 + (size_t)mt * 256 * 1024) * 2; }
    __device__ __forceinline__ const char* bptr(const Unit& u) const { return B + (size_t)(u.pm >> 4) * 256 * 2048 * 2; }
};
struct SchedMoe {
    const char* A; const char* B; size_t at, bt_tile, bt_exp; int G, c, nN, tile0, ntile; const LAS int* seg;
    __device__ __forceinline__ bool next(int i, Unit& u) const { const int nwg = ntile * nN; const int L = i * G + c; if (L >= nwg) return false;
        int wgid = L; { const int q = nwg / NXCD, r = nwg % NXCD, xcd = wgid % NXCD, off = wgid / NXCD; wgid = (xcd < r ? xcd * (q + 1) : r * (q + 1) + (xcd - r) * q) + off; }
        const int nig = WGM * nN, gid = wgid / nig, fm = gid * WGM, gsz = (ntile - fm) < WGM ? (ntile - fm) : WGM;
        u.pm = tile0 + fm + ((wgid % nig) % gsz); u.pn = (wgid % nig) / gsz; return true; }
    __device__ __forceinline__ int expert(int pm) const { const int r0 = pm * 256; int e = 0;
#pragma unroll
        for (int j = 1; j < NE; ++j) e += (seg[j] <= r0) ? 1 : 0;
        return __builtin_amdgcn_readfirstlane(e); }
    __device__ __forceinline__ const char* aptr(const Unit& u) const { return A + (size_t)(u.pm - tile0) * at; }
    __device__ __forceinline__ const char* bptr(const Unit& u) const { return B + (size_t)expert(u.pm) * bt_exp + (size_t)u.pn * bt_tile; }
};

struct SchedMoeG : SchedMoe {
    const LAS int* lidx;
    __device__ __forceinline__ const char* aptr(const Unit&) const { return A; }
};

#define EPI_ARGS const f32x4 (&acc)[2][2][4][2], const Unit& u, int wr, int wc, int fr, int fq
struct EpiZ {
    bf16* Z; bf16* CMP; bf16* KVS;
    __device__ __forceinline__ void operator()(EPI_ARGS) const {
        const int row0 = u.pm * BM + wr * 64 + fr;
        if (u.pn == 20) {
#pragma unroll
            for (int ai = 0; ai < 2; ++ai)
#pragma unroll
                for (int m = 0; m < 4; ++m) { bf16* rowp = KVS + (size_t)(row0 + ai * HALF + m * 16) * KVSP + wc * 32 + 8 * fq;
#pragma unroll
                    for (int bj = 0; bj < 2; ++bj) *(GAS bf16x8*)(rowp + bj * HALF) = pack8(acc[ai][bj][m][0], acc[ai][bj][m][1]); }
        } else if (u.pn < 25) {
#pragma unroll
            for (int ai = 0; ai < 2; ++ai)
#pragma unroll
                for (int m = 0; m < 4; ++m) { bf16* rowp = Z + (size_t)(row0 + ai * HALF + m * 16) * ZP + u.pn * BM + wc * 32 + 8 * fq;
#pragma unroll
                    for (int bj = 0; bj < 2; ++bj) *(GAS bf16x8*)(rowp + bj * HALF) = pack8(acc[ai][bj][m][0], acc[ai][bj][m][1]); }
        } else {
#pragma unroll
            for (int ai = 0; ai < 2; ++ai)
#pragma unroll
                for (int m = 0; m < 4; ++m) { const int row = row0 + ai * HALF + m * 16, b = row >> 14, t = row & (SEQ - 1);
#pragma unroll
                    for (int bj = 0; bj < 2; ++bj) { const int lc = bj * HALF + wc * 32 + 8 * fq, hh = lc >> 6, d = lc & 63;
                        *(GAS bf16x8*)(CMP + ((size_t)(b * 4 + hh) * SEQ + t) * 64 + d) = pack8(acc[ai][bj][m][0], acc[ai][bj][m][1]); } }
        }
    }
};
struct EpiBf16 {
    bf16* O; int ldc;
    __device__ __forceinline__ void operator()(EPI_ARGS) const {
        const int row0 = u.pm * BM + wr * 64 + fr;
#pragma unroll
        for (int ai = 0; ai < 2; ++ai)
#pragma unroll
            for (int m = 0; m < 4; ++m) { bf16* rowp = O + (size_t)(row0 + ai * HALF + m * 16) * ldc + u.pn * BM + wc * 32 + 8 * fq;
#pragma unroll
                for (int bj = 0; bj < 2; ++bj) *(GAS bf16x8*)(rowp + bj * HALF) = pack8(acc[ai][bj][m][0], acc[ai][bj][m][1]); }
    }
};
struct EpiGateSum {
    const bf16* BP; const float* bg; bf16* MG; float dsc;
    __device__ __forceinline__ void operator()(EPI_ARGS) const {
        const int row0 = u.pm * BM + wr * 64 + fr, c0 = 64 * u.pn + 16 * wc + 4 * fq;
        f32x4 bgv[4];
#pragma unroll
        for (int mm = 0; mm < 4; ++mm) bgv[mm] = *(const GAS f32x4*)(bg + mm * D + c0);
#pragma unroll
        for (int ai = 0; ai < 2; ++ai)
#pragma unroll
            for (int m = 0; m < 4; ++m) { const size_t row = (size_t)(row0 + ai * HALF + m * 16); f32x4 sum = {0.f, 0.f, 0.f, 0.f};
#pragma unroll
                for (int bj = 0; bj < 2; ++bj)
#pragma unroll
                    for (int n = 0; n < 2; ++n) { const int mm = 2 * bj + n; const f32x4 a = acc[ai][bj][m][n] * dsc + bgv[mm];
                        const f32x4 bp = unpack4(*(const GAS u32x2*)(BP + row * 4096 + mm * D + c0));
#pragma unroll
                        for (int i = 0; i < 4; ++i) sum[i] += sigmoidf_(a[i]) * bp[i]; }
                *(GAS u32x2*)(MG + row * D + c0) = pack4(sum); }
    }
};
struct EpiResid {
    const float* xin; float* out;
    __device__ __forceinline__ void operator()(EPI_ARGS) const {
        const int row0 = u.pm * BM + wr * 64 + fr, col0 = u.pn * BM + wc * 32 + 8 * fq;
#pragma unroll
        for (int ai = 0; ai < 2; ++ai)
#pragma unroll
            for (int m = 0; m < 4; ++m) { const size_t ro = (size_t)(row0 + ai * HALF + m * 16) * D + col0;
#pragma unroll
                for (int bj = 0; bj < 2; ++bj)
#pragma unroll
                    for (int n = 0; n < 2; ++n) { const f32x4 xv = *(const GAS f32x4*)(xin + ro + bj * HALF + 4 * n);
                        *(GAS f32x4*)(out + ro + bj * HALF + 4 * n) = xv * ALPHA + acc[ai][bj][m][n]; } }
    }
};
struct EpiUp {
    bf16* H; int ldh; int nup; int row_off; const float* pgb; bf16* PW;
    __device__ __forceinline__ void operator()(EPI_ARGS) const {
        const int row0 = u.pm * BM + wr * 64 + fr;
        if (u.pn < nup) {
            const int f0 = 128 * u.pn + 32 * wc + 8 * fq;
#pragma unroll
            for (int ai = 0; ai < 2; ++ai)
#pragma unroll
                for (int m = 0; m < 4; ++m) { f32x4 h[2];
#pragma unroll
                    for (int n = 0; n < 2; ++n)
#pragma unroll
                        for (int i = 0; i < 4; ++i) h[n][i] = siluf_(acc[ai][0][m][n][i]) * acc[ai][1][m][n][i];
                    *(GAS bf16x8*)(H + (size_t)(row0 + ai * HALF + m * 16 - row_off) * ldh + f0) = pack8(h[0], h[1]); }
        } else {
            const int q = u.pn - nup;
#pragma unroll
            for (int bj = 0; bj < 2; ++bj) { const int col = 256 * q + 128 * bj + 32 * wc + 8 * fq; const f32x4 b0 = *(const GAS f32x4*)(pgb + col), b1 = *(const GAS f32x4*)(pgb + col + 4);
#pragma unroll
                for (int ai = 0; ai < 2; ++ai)
#pragma unroll
                    for (int m = 0; m < 4; ++m) { bf16* p = PW + (size_t)(row0 + ai * HALF + m * 16) * D + col; const u32x4 w = *(const GAS u32x4*)p;
                        const f32x4 p0 = unpack4((u32x2){w.x, w.y}), p1 = unpack4((u32x2){w.z, w.w}); f32x4 r0, r1;
#pragma unroll
                        for (int i = 0; i < 4; ++i) { r0[i] = sigmoidf_(acc[ai][bj][m][0][i] + b0[i]) * p0[i]; r1[i] = sigmoidf_(acc[ai][bj][m][1][i] + b1[i]) * p1[i]; }
                        *(GAS bf16x8*)p = pack8(r0, r1); } }
        }
    }
};
struct EpiDown {
    bf16* out; const bf16* PL; float sc;
    __device__ __forceinline__ void operator()(EPI_ARGS) const {
        const int row0 = u.pm * BM + wr * 64 + fr, col0 = u.pn * BM + wc * 32 + 8 * fq;
#pragma unroll
        for (int ai = 0; ai < 2; ++ai)
#pragma unroll
            for (int m = 0; m < 4; ++m) { const size_t ro = (size_t)(row0 + ai * HALF + m * 16) * D + col0;
#pragma unroll
                for (int bj = 0; bj < 2; ++bj) { const u32x4 w = *(const GAS u32x4*)(PL + ro + bj * HALF); const f32x4 p0 = unpack4((u32x2){w.x, w.y}), p1 = unpack4((u32x2){w.z, w.w});
                    const u32x4 xw = *(const GAS u32x4*)(out + ro + bj * HALF); const f32x4 x0 = unpack4((u32x2){xw.x, xw.y}), x1 = unpack4((u32x2){xw.z, xw.w});
                    const u32x2 r0 = pack4(x0 * ALPHA + acc[ai][bj][m][0] * sc + p0), r1 = pack4(x1 * ALPHA + acc[ai][bj][m][1] * sc + p1);
                    *(GAS u32x4*)(out + ro + bj * HALF) = (u32x4){r0.x, r0.y, r1.x, r1.y}; } }
    }
};
struct EpiUp8 {
    unsigned char* H; int ldh; int row_off;
    __device__ __forceinline__ void operator()(EPI_ARGS) const {
        const int row0 = u.pm * BM + wr * 64 + fr, f0 = 128 * u.pn + 32 * wc + 8 * fq;
        constexpr float DG = 1.f / (F8_SX * F8_SG), DU = F8_SH / (F8_SX * F8_SU);
#pragma unroll
        for (int ai = 0; ai < 2; ++ai)
#pragma unroll
            for (int m = 0; m < 4; ++m) { f32x4 h[2];
#pragma unroll
                for (int n = 0; n < 2; ++n)
#pragma unroll
                    for (int i = 0; i < 4; ++i) h[n][i] = siluf_(acc[ai][0][m][n][i] * DG) * (acc[ai][1][m][n][i] * DU);
                const u32x2 w = {cvt4_fp8(h[0][0], h[0][1], h[0][2], h[0][3]), cvt4_fp8(h[1][0], h[1][1], h[1][2], h[1][3])};
                *(GAS u32x2*)(H + (size_t)(row0 + ai * HALF + m * 16 - row_off) * ldh + f0) = w; }
    }
};
struct EpiMoeDown {
    bf16* Y; const float* roww; float sc;
    __device__ __forceinline__ void operator()(EPI_ARGS) const {
        const int row0 = u.pm * BM + wr * 64 + fr;
#pragma unroll
        for (int ai = 0; ai < 2; ++ai)
#pragma unroll
            for (int m = 0; m < 4; ++m) { const int row = row0 + ai * HALF + m * 16; const float w = roww[row] * sc; bf16* rowp = Y + (size_t)row * D + u.pn * BM + wc * 32 + 8 * fq;
#pragma unroll
                for (int bj = 0; bj < 2; ++bj) *(GAS bf16x8*)(rowp + bj * HALF) = pack8(acc[ai][bj][m][0] * w, acc[ai][bj][m][1] * w); }
    }
};
struct EpiHid {
    bf16* HID; const float* b1p;
    __device__ __forceinline__ void operator()(EPI_ARGS) const {
        const int L = u.pm, kv2 = L >> 4, seg = (L >> 2) & 3, mt = L & 3; const int rb = kv2 * 4096 + seg * 1024 + mt * 256 + wr * 64 + fr, col = wc * 32 + 8 * fq;
        const f32x4 b0 = *(const GAS f32x4*)(b1p + kv2 * 128 + col), b1 = *(const GAS f32x4*)(b1p + kv2 * 128 + col + 4);
#pragma unroll
        for (int ai = 0; ai < 2; ++ai)
#pragma unroll
            for (int m = 0; m < 4; ++m) { f32x4 r0, r1;
#pragma unroll
                for (int i = 0; i < 4; ++i) { r0[i] = gelu_tanh(acc[ai][0][m][0][i] + b0[i]); r1[i] = gelu_tanh(acc[ai][0][m][1][i] + b1[i]); }
                *(GAS bf16x8*)(HID + (size_t)(rb + ai * HALF + m * 16) * 128 + col) = pack8(r0, r1); }
    }
};
#undef EPI_ARGS
}

namespace att {
constexpr int RS = 128;
constexpr int TILE_B = 64 * RS;
constexpr int OFF_IMP = 4 * TILE_B;
constexpr int IMP_RS = 528;
constexpr int OFF_SEL = OFF_IMP + 128 * IMP_RS;
static_assert(6 * 2 * TILE_B <= OFF_SEL, "selected-pass slots end below the selection masks");
constexpr int LDS_END = OFF_SEL + 128 * 32;
static_assert(OFF_IMP + 128 * IMP_RS <= OFF_SEL, "importance rows end below the selection masks");
constexpr float SC2 = 0.125f * LOG2E;
constexpr float NEG_INF = -__builtin_inff();

template <int NB> struct AState { f32x4 o[NB][4]; f32x4 la[NB]; float m[NB]; };
template <int NB> __device__ __forceinline__ void state_init(AState<NB>& A) {
#pragma unroll
    for (int nb = 0; nb < NB; ++nb) { A.m[nb] = -1e30f; A.la[nb] = (f32x4){0.f, 0.f, 0.f, 0.f};
#pragma unroll
        for (int dt = 0; dt < 4; ++dt) A.o[nb][dt] = (f32x4){0.f, 0.f, 0.f, 0.f}; }
}
struct KVRegs { u32x4 k, v; };
__device__ __forceinline__ void kv_issue(KVRegs& r, const bf16* kp, const bf16* vp) { r.k = *(const GAS u32x4*)kp; r.v = *(const GAS u32x4*)vp; }
__device__ __forceinline__ void kv_commit(LAS unsigned char* lds, int buf, const KVRegs& r, int tid) {
    LAS unsigned char* p = lds + buf * 2 * TILE_B + (tid >> 3) * RS + (((tid & 7) ^ ((tid >> 4) & 7)) * 16);
    *(LAS u32x4*)p = r.k; *(LAS u32x4*)(p + TILE_B) = r.v;
}
template <int NB> __device__ __forceinline__ void qk_tile(f32x4 (&st)[NB][4], const LAS unsigned char* Kl, const bf16x8 (&qf)[NB][2], int fr, int fq) {
    bf16x8 kf[4][2];
#pragma unroll
    for (int sub = 0; sub < 4; ++sub)
#pragma unroll
        for (int ks = 0; ks < 2; ++ks) kf[sub][ks] = *(const LAS bf16x8*)(Kl + (sub * 16 + fr) * RS + (((ks * 4 + fq) ^ (fr >> 1)) * 16));
    __builtin_amdgcn_sched_barrier(0);
    __builtin_amdgcn_s_setprio(1);
#pragma unroll
    for (int sub = 0; sub < 4; ++sub) {
#pragma unroll
        for (int nb = 0; nb < NB; ++nb) st[nb][sub] = (f32x4){0.f, 0.f, 0.f, 0.f};
#pragma unroll
        for (int ks = 0; ks < 2; ++ks)
#pragma unroll
            for (int nb = 0; nb < NB; ++nb) st[nb][sub] = __builtin_amdgcn_mfma_f32_16x16x32_bf16(kf[sub][ks], qf[nb][ks], st[nb][sub], 0, 0, 0);
    }
    __builtin_amdgcn_s_setprio(0);
}
template <int NB> __device__ __forceinline__ void pv_tile(f32x4 (&o)[NB][4], const LAS unsigned char* Vl, const bf16x8 (&pf)[NB][2], int fr, int fq) {
    __builtin_amdgcn_s_setprio(1);
#pragma unroll
    for (int kk = 0; kk < 2; ++kk)
#pragma unroll
        for (int dt = 0; dt < 4; ++dt) {
            const LAS unsigned char* p = Vl + (32 * kk + 4 * fq + (fr >> 2)) * RS + (((dt * 2 + ((fr & 3) >> 1)) ^ (2 * fq + (fr >> 3))) * 16) + 8 * (fr & 1);
            const s16x4 lo = __builtin_amdgcn_ds_read_tr16_b64_v4i16((LAS s16x4*)p);
            const s16x4 hi = __builtin_amdgcn_ds_read_tr16_b64_v4i16((LAS s16x4*)(p + 16 * RS));
            const bf16x8 vf = __builtin_shufflevector(lo, hi, 0, 1, 2, 3, 4, 5, 6, 7);
#pragma unroll
            for (int nb = 0; nb < NB; ++nb) o[nb][dt] = __builtin_amdgcn_mfma_f32_16x16x32_bf16(vf, pf[nb][kk], o[nb][dt], 0, 0, 0);
        }
    __builtin_amdgcn_s_setprio(0);
}
template <int NB, bool EMASK, bool DO_PV> __device__ __forceinline__ void attn_rest(AState<NB>& A, f32x4 (&st)[NB][4], const LAS unsigned char* Vl,
                                                            int kp0, const int (&lo)[NB], const int (&hi)[NB], float lane_bias, int fr, int fq) {
    float alpha[NB], nbias[NB]; bool moved = false;
#pragma unroll
    for (int nb = 0; nb < NB; ++nb) {
        float mx = NEG_INF;
#pragma unroll
        for (int sub = 0; sub < 4; ++sub)
#pragma unroll
            for (int r = 0; r < 4; ++r) {
                if constexpr (EMASK) { const int kpos = kp0 + sub * 16 + 4 * fq + r; st[nb][sub][r] = (kpos >= lo[nb] && kpos <= hi[nb]) ? st[nb][sub][r] : NEG_INF; }
                mx = fmaxf(mx, st[nb][sub][r]); }
        mx = quad_max(mx);
        const float mnew = fmaxf(A.m[nb], __builtin_fmaf(mx, SC2, lane_bias)); nbias[nb] = lane_bias - mnew; alpha[nb] = ex2(A.m[nb] - mnew); moved = moved || (mnew != A.m[nb]); A.m[nb] = mnew;
    }
    if (__any(moved)) {
#pragma unroll
        for (int nb = 0; nb < NB; ++nb) { A.la[nb] = A.la[nb] * alpha[nb];
            if constexpr (DO_PV) {
#pragma unroll
                for (int dt = 0; dt < 4; ++dt) A.o[nb][dt] = A.o[nb][dt] * alpha[nb]; } }
    }
    bf16x8 vf[2][4];
    if constexpr (DO_PV) {
#pragma unroll
        for (int dt = 0; dt < 4; ++dt) {
            const LAS unsigned char* p = Vl + (4 * fq + (fr >> 2)) * RS + (((dt * 2 + ((fr & 3) >> 1)) ^ (2 * fq + (fr >> 3))) * 16) + 8 * (fr & 1);
            const s16x4 lo4 = __builtin_amdgcn_ds_read_tr16_b64_v4i16((LAS s16x4*)p);
            const s16x4 hi4 = __builtin_amdgcn_ds_read_tr16_b64_v4i16((LAS s16x4*)(p + 16 * RS));
            vf[0][dt] = __builtin_shufflevector(lo4, hi4, 0, 1, 2, 3, 4, 5, 6, 7); }
#pragma unroll
        for (int dt = 0; dt < 4; ++dt) {
            const LAS unsigned char* p = Vl + (32 + 4 * fq + (fr >> 2)) * RS + (((dt * 2 + ((fr & 3) >> 1)) ^ (2 * fq + (fr >> 3))) * 16) + 8 * (fr & 1);
            const s16x4 lo4 = __builtin_amdgcn_ds_read_tr16_b64_v4i16((LAS s16x4*)p);
            const s16x4 hi4 = __builtin_amdgcn_ds_read_tr16_b64_v4i16((LAS s16x4*)(p + 16 * RS));
            vf[1][dt] = __builtin_shufflevector(lo4, hi4, 0, 1, 2, 3, 4, 5, 6, 7); }
    }
    bf16x8 pf[NB][2];
#pragma unroll
    for (int nb = 0; nb < NB; ++nb) {
#pragma unroll
        for (int sub = 0; sub < 4; ++sub)
#pragma unroll
            for (int r = 0; r < 4; ++r) st[nb][sub][r] = ex2(__builtin_fmaf(st[nb][sub][r], SC2, nbias[nb]));
        pf[nb][0] = pack8(st[nb][0], st[nb][1]); pf[nb][1] = pack8(st[nb][2], st[nb][3]);
    }
    __builtin_amdgcn_s_setprio(1);
    { const bf16x8 ones = {0x3F80, 0x3F80, 0x3F80, 0x3F80, 0x3F80, 0x3F80, 0x3F80, 0x3F80};
#pragma unroll
      for (int kk = 0; kk < 2; ++kk)
#pragma unroll
        for (int nb = 0; nb < NB; ++nb) A.la[nb] = __builtin_amdgcn_mfma_f32_16x16x32_bf16(ones, pf[nb][kk], A.la[nb], 0, 0, 0); }
    if constexpr (DO_PV) {
#pragma unroll
        for (int kk = 0; kk < 2; ++kk)
#pragma unroll
            for (int dt = 0; dt < 4; ++dt)
#pragma unroll
                for (int nb = 0; nb < NB; ++nb) A.o[nb][dt] = __builtin_amdgcn_mfma_f32_16x16x32_bf16(vf[kk][dt], pf[nb][kk], A.o[nb][dt], 0, 0, 0);
    }
    __builtin_amdgcn_s_setprio(0);
}

template <int NB, bool EMASK, bool DO_PV> __device__ __forceinline__ void attn_tile(AState<NB>& A, const LAS unsigned char* Kl, const LAS unsigned char* Vl, const bf16x8 (&qf)[NB][2],
                                                            int kp0, const int (&lo)[NB], const int (&hi)[NB], float lane_bias, int fr, int fq) {
    f32x4 st[NB][4];
    qk_tile<NB>(st, Kl, qf, fr, fq);
    attn_rest<NB, EMASK, DO_PV>(A, st, Vl, kp0, lo, hi, lane_bias, fr, fq);
}
__device__ __forceinline__ void k_frags(bf16x8 (&kfr)[4][2], const LAS unsigned char* Kl, int fr, int fq) {
#pragma unroll
    for (int sub = 0; sub < 4; ++sub)
#pragma unroll
        for (int ks = 0; ks < 2; ++ks) kfr[sub][ks] = *(const LAS bf16x8*)(Kl + (sub * 16 + fr) * RS + (((ks * 4 + fq) ^ (fr >> 1)) * 16));
}
__device__ __forceinline__ void qk_pre(f32x4 (&st)[1][4], const bf16x8 (&kfr)[4][2], const bf16x8 (&qf)[1][2]) {
    __builtin_amdgcn_s_setprio(1);
#pragma unroll
    for (int sub = 0; sub < 4; ++sub) { st[0][sub] = (f32x4){0.f, 0.f, 0.f, 0.f};
#pragma unroll
        for (int ks = 0; ks < 2; ++ks) st[0][sub] = __builtin_amdgcn_mfma_f32_16x16x32_bf16(kfr[sub][ks], qf[0][ks], st[0][sub], 0, 0, 0); }
    __builtin_amdgcn_s_setprio(0);
}

template <int NB> struct BandedArgs {
    const bf16* Q; const bf16* K; const bf16* V; int pitch;
    int tok0, dil;
    int p0, W;
    int qcol_nb, qrow_nb, rpw;
    bf16* O; int opitch, ocol_nb;
    float* lse; int lse_stride;
    const float* sink;
};
template <int NB, bool ALLSTAGE = false> __device__ __forceinline__ void banded_unit(LAS unsigned char* lds, const BandedArgs<NB>& a) {
    int tid = threadIdx.x; asm volatile("" : "+v"(tid));
    const int wave = __builtin_amdgcn_readfirstlane(tid >> 6), lane = tid & 63, fr = lane & 15, fq = lane >> 4;
    const int wq0 = a.p0 + wave * a.rpw;
    bf16x8 qf[NB][2]; int qpos[NB], lo[NB];
#pragma unroll
    for (int nb = 0; nb < NB; ++nb) { qpos[nb] = wq0 + nb * a.qrow_nb + fr; lo[nb] = qpos[nb] - a.W;
        const bf16* qp = a.Q + (size_t)(a.tok0 + a.dil * qpos[nb]) * a.pitch + nb * a.qcol_nb + fq * 8;
        qf[nb][0] = *(const GAS bf16x8*)qp; qf[nb][1] = *(const GAS bf16x8*)(qp + 32); }
    AState<NB> A; state_init<NB>(A);
    int kstart = a.p0 - a.W; kstart = kstart < 0 ? 0 : (kstart & ~63);
    const int nt = (a.p0 + 8 * a.rpw - kstart) >> 6;
    const int wlo = wq0 - a.W, whi = wq0 + a.rpw - 1;
    const int srow = tid >> 3, sch8 = ((tid & 7) ^ ((tid >> 4) & 7)) * 8;
    const unsigned ldsb = (unsigned)__builtin_amdgcn_readfirstlane((int)(unsigned)(size_t)lds + wave * 1024);
#define DMA_TILE(slot, key0) { const size_t ro = (size_t)(a.tok0 + a.dil * ((key0) + srow)) * a.pitch + sch8; \
        const unsigned lk = ldsb + (unsigned)((slot) * 2 * TILE_B), lv = lk + (unsigned)TILE_B; unsigned m0s; \
        asm volatile("s_mov_b32 %0, m0\n\ts_mov_b32 m0, %1\n\ts_nop 0\n\tglobal_load_lds_dwordx4 %3, off\n\ts_mov_b32 m0, %2\n\ts_nop 0\n\tglobal_load_lds_dwordx4 %4, off\n\ts_mov_b32 m0, %0" \
                     : "=&s"(m0s) : "s"(lk), "s"(lv), "v"(a.K + ro), "v"(a.V + ro) : "memory"); }
    if constexpr (ALLSTAGE) {
#pragma unroll
        for (int tt = 0; tt < 6; ++tt) if (tt < nt) DMA_TILE(tt, kstart + 64 * tt)
    } else {
        DMA_TILE(0, kstart)
        if (nt > 1) DMA_TILE(1, kstart + 64)
    }
    __builtin_amdgcn_s_waitcnt(0x0F70);
    __syncthreads();
    int tA = (wlo - kstart) >> 6; tA = tA < 0 ? 0 : tA;
    int tB = (whi - kstart) >> 6; tB = tB > nt - 1 ? nt - 1 : tB;
    int tF0 = (whi - a.W - kstart + 63) >> 6; tF0 = tF0 < tA ? tA : tF0;
    int tF1 = (wq0 - 63 - kstart) >> 6; tF1 = tF1 > tB ? tB : tF1;
    if (tF1 < tF0) { tF0 = tB + 1; tF1 = tB; }
#define BAND_ITER(...) { const int kp0 = kstart + 64 * t; \
        if (!(t & 1)) { \
            if (t + 2 < nt) DMA_TILE((t + 2) & 3, kp0 + 128) \
            if (t + 3 < nt) DMA_TILE((t + 3) & 3, kp0 + 192) } \
        { const LAS unsigned char* Kl = lds + (t & 3) * 2 * TILE_B; (void)Kl; __VA_ARGS__ } \
        if ((t & 1) || t == nt - 1) { asm volatile("s_waitcnt vmcnt(0)" ::: "memory"); __syncthreads(); } }
    int t = 0;
    if constexpr (ALLSTAGE) {
#define ALL_ITER(EM) { const int kp0 = kstart + 64 * t; const LAS unsigned char* Kl = lds + t * 2 * TILE_B; attn_tile<NB, EM, true>(A, Kl, Kl + TILE_B, qf, kp0, lo, qpos, 0.f, fr, fq); }
        for (t = tA; t < tF0; ++t) ALL_ITER(true)
        for (; t <= tF1; ++t) ALL_ITER(false)
        for (; t <= tB; ++t) ALL_ITER(true)
#undef ALL_ITER
    } else {
    for (; t < tA; ++t) BAND_ITER(;)
    for (; t < tF0; ++t) BAND_ITER((attn_tile<NB, true, true>(A, Kl, Kl + TILE_B, qf, kp0, lo, qpos, 0.f, fr, fq));)
    for (; t <= tF1; ++t) BAND_ITER((attn_tile<NB, false, true>(A, Kl, Kl + TILE_B, qf, kp0, lo, qpos, 0.f, fr, fq));)
    for (; t <= tB; ++t) BAND_ITER((attn_tile<NB, true, true>(A, Kl, Kl + TILE_B, qf, kp0, lo, qpos, 0.f, fr, fq));)
    for (; t < nt; ++t) BAND_ITER(;)
    }
#undef BAND_ITER
#undef DMA_TILE
#pragma unroll
    for (int nb = 0; nb < NB; ++nb) {
        const float lt = A.la[nb][0];
        const float lse = (A.m[nb] + __builtin_amdgcn_logf(lt)) * LN2;
        float sc = 1.f / lt;
        if (a.sink) sc *= sigmoidf_(lse - a.sink[nb]);
        const size_t tok = (size_t)(a.tok0 + a.dil * qpos[nb]);
        bf16* op = a.O + tok * a.opitch + nb * a.ocol_nb + 4 * fq;
#pragma unroll
        for (int dt = 0; dt < 4; ++dt) *(GAS u32x2*)(op + dt * 16) = pack4(A.o[nb][dt] * sc);
        if (a.lse && fq == 0) a.lse[tok * a.lse_stride] = lse;
    }
}

__device__ __forceinline__ void nsa_unit(LAS unsigned char* lds, const bf16* Z, const bf16* KVS, const bf16* KC, const bf16* VC, const bf16* BR, bf16* BRO, int b, int kv, int t0) {
    int tid = threadIdx.x; asm volatile("" : "+v"(tid));
    const int wave = __builtin_amdgcn_readfirstlane(tid >> 6), lane = tid & 63, fr = lane & 15, fq = lane >> 4;
    const int tq = t0 + wave * 16 + fr; const size_t gt = (size_t)b * SEQ + tq;
    const int srow = tid >> 3, sch = tid & 7;
    bf16x8 qf[3][2];
#pragma unroll
    for (int g = 0; g < 3; ++g) { const bf16* qp = Z + gt * ZP + ZC_QC + (kv * 3 + g) * 64 + fq * 8; qf[g][0] = *(const GAS bf16x8*)qp; qf[g][1] = *(const GAS bf16x8*)(qp + 32); }
    const int cm = (tq - 31) >> 4;
    const int ntc = (((t0 + 96) >> 4) >> 6) + 1;
    const int cmw = (t0 + wave * 16 + 15 - 31) >> 4;
    KVRegs r;
    AState<3> A; state_init<3>(A);
    int lo3[3], hi3[3];
#pragma unroll
    for (int g = 0; g < 3; ++g) { lo3[g] = 0; hi3[g] = cm; }
    const int cmin_w = (t0 + wave * 16 - 31) >> 4;
    kv_issue(r, KC + (size_t)srow * 64 + sch * 8, VC + (size_t)srow * 64 + sch * 8);
    kv_commit(lds, 0, r, tid);
    __syncthreads();
    int tcF = cmin_w < 63 ? 0 : ((cmin_w - 63) >> 6) + 1;
    int tcB = cmw < 0 ? 0 : (cmw >> 6) + 1;
    tcF = tcF > ntc ? ntc : tcF; tcB = tcB > ntc ? ntc : tcB; tcB = tcB < tcF ? tcF : tcB;
#define CMP_ITER(...) { const int c0 = 64 * t; \
        if (t + 1 < ntc) { const size_t ro = (size_t)(c0 + 64 + srow) * 64 + sch * 8; kv_issue(r, KC + ro, VC + ro); } \
        { const LAS unsigned char* Kl = lds + (t & 1) * 2 * TILE_B; (void)Kl; __VA_ARGS__ } \
        if (t + 1 < ntc) kv_commit(lds, (t + 1) & 1, r, tid); \
        __syncthreads(); }
    { int t = 0;
      for (; t < tcF; ++t) CMP_ITER((attn_tile<3, false, false>(A, Kl, Kl + TILE_B, qf, c0, lo3, hi3, 0.f, fr, fq));)
      for (; t < tcB; ++t) CMP_ITER((attn_tile<3, true, false>(A, Kl, Kl + TILE_B, qf, c0, lo3, hi3, 0.f, fr, fq));)
      for (; t < ntc; ++t) CMP_ITER(;) }
    float linv[3], m1[3];
#pragma unroll
    for (int g = 0; g < 3; ++g) { const float lt = A.la[g][0]; linv[g] = lt > 0.f ? 1.f / lt : 0.f; m1[g] = A.m[g]; }
    { LAS unsigned* ip = (LAS unsigned*)(lds + OFF_IMP + wave * 16 * IMP_RS);
        for (int i = lane; i < 16 * IMP_RS / 4; i += 64) ip[i] = 0u; }
    state_init<3>(A);
    kv_issue(r, KC + (size_t)srow * 64 + sch * 8, VC + (size_t)srow * 64 + sch * 8);
    kv_commit(lds, 0, r, tid);
    __syncthreads();
    float bprev = 0.f;
    for (int t = 0; t < ntc; ++t) {
        const int c0 = 64 * t;
        if (t + 1 < ntc) { const size_t ro = (size_t)(c0 + 64 + srow) * 64 + sch * 8; kv_issue(r, KC + ro, VC + ro); }
        if (c0 <= cmw) {
            const LAS unsigned char* Kl = lds + (t & 1) * 2 * TILE_B;
            f32x4 st[3][4];
            qk_tile<3>(st, Kl, qf, fr, fq);
            bf16x8 pf[3][2];
#pragma unroll
            for (int g = 0; g < 3; ++g) {
#pragma unroll
                for (int sub = 0; sub < 4; ++sub)
#pragma unroll
                    for (int q = 0; q < 4; ++q) { const int c = c0 + sub * 16 + 4 * fq + q; st[g][sub][q] = (c <= cm) ? ex2(__builtin_fmaf(st[g][sub][q], SC2, -m1[g])) : 0.f; }
                pf[g][0] = pack8(st[g][0], st[g][1]); pf[g][1] = pack8(st[g][2], st[g][3]);
            }
#pragma unroll
            for (int sub = 0; sub < 4; ++sub) {
                float av = 0.f, bcur = 0.f;
#pragma unroll
                for (int g = 0; g < 3; ++g) { av += linv[g] * ((st[g][sub][0] + st[g][sub][1]) + (st[g][sub][2] + st[g][sub][3])); bcur += linv[g] * st[g][sub][3]; }
                const int src = (lane + 48) & 63;
                const float x1 = __shfl(bcur, src), x2 = __shfl(bprev, src);
                const float bsel = (fq == 0) ? x2 : x1;
                bprev = bcur;
                const int j = t * 16 + sub * 4 + fq;
                *(LAS _Float16*)(lds + OFF_IMP + (wave * 16 + fr) * IMP_RS + j * 2) = (_Float16)(av + bsel);
            }
            pv_tile<3>(A.o, Kl + TILE_B, pf, fr, fq);
        }
        if (t + 1 < ntc) kv_commit(lds, (t + 1) & 1, r, tid);
        __syncthreads();
    }
    u32x2 part[3][4];
    {
        const bf16* gp = Z + gt * ZP + ZC_GN;
#pragma unroll
        for (int g = 0; g < 3; ++g) {
            const int h = kv * 3 + g;
            const float gc = sigmoidf_(bf2f(gp[h])), gw = sigmoidf_(bf2f(gp[12 + h]));
            const bf16* wp = BR + gt * BRW + 768 + h * 64 + 4 * fq;
#pragma unroll
            for (int dt = 0; dt < 4; ++dt) { const f32x4 ow = unpack4(*(const GAS u32x2*)(wp + dt * 16)); part[g][dt] = pack4(A.o[g][dt] * (linv[g] * gc) + ow * gw); }
        }
    }
    __builtin_amdgcn_wave_barrier(); asm volatile("s_waitcnt lgkmcnt(0)" ::: "memory");
    for (int qi = 0; qi < 16; ++qi) {
        const int tqq = t0 + wave * 16 + qi, cur = tqq >> 6;
        const LAS unsigned short* ir = (const LAS unsigned short*)(lds + OFF_IMP + (wave * 16 + qi) * IMP_RS);
        const int j0 = lane, j1 = lane + 64, j2 = lane + 128, j3 = lane + 192, f2 = cur - 1;
        const bool fo0 = (j0 == 0) || (j0 == cur) || (j0 == f2), fo1 = (j1 == cur) || (j1 == f2), fo2 = (j2 == cur) || (j2 == f2), fo3 = (j3 == cur) || (j3 == f2);
        const unsigned k0 = (j0 <= cur && !fo0) ? (unsigned)ir[j0] + 1u : 0u, k1 = (j1 <= cur && !fo1) ? (unsigned)ir[j1] + 1u : 0u;
        const unsigned k2 = (j2 <= cur && !fo2) ? (unsigned)ir[j2] + 1u : 0u, k3 = (j3 <= cur && !fo3) ? (unsigned)ir[j3] + 1u : 0u;
        const int nforced = cur >= 2 ? 3 : cur + 1, ntot = cur + 1 < 16 ? cur + 1 : 16, npick = ntot - nforced;
        unsigned T = 0xffffffffu;
        if (npick > 0) { T = 0u;
            for (int b = 14; b >= 0; --b) { const unsigned c = T | (1u << b);
                const int cnt = __popcll(__ballot(k0 >= c)) + __popcll(__ballot(k1 >= c)) + __popcll(__ballot(k2 >= c)) + __popcll(__ballot(k3 >= c));
                if (cnt >= npick) T = c; } }
        const unsigned long long g0 = __ballot(k0 > T), g1 = __ballot(k1 > T), g2 = __ballot(k2 > T), g3 = __ballot(k3 > T);
        const unsigned long long e0 = __ballot(k0 == T), e1 = __ballot(k1 == T), e2 = __ballot(k2 == T), e3 = __ballot(k3 == T);
        const int need = npick - (__popcll(g0) + __popcll(g1) + __popcll(g2) + __popcll(g3));
        const unsigned long long lt_mask = (1ull << lane) - 1ull;
        const int r0 = __popcll(e0 & lt_mask), r1 = __popcll(e0) + __popcll(e1 & lt_mask), r2 = __popcll(e0) + __popcll(e1) + __popcll(e2 & lt_mask), r3 = __popcll(e0) + __popcll(e1) + __popcll(e2) + __popcll(e3 & lt_mask);
        const bool s0 = fo0 || (k0 > T) || (k0 == T && r0 < need), s1 = (fo1 && j1 <= cur) || (k1 > T) || (k1 == T && r1 < need);
        const bool s2 = (fo2 && j2 <= cur) || (k2 > T) || (k2 == T && r2 < need), s3 = (fo3 && j3 <= cur) || (k3 > T) || (k3 == T && r3 < need);
        const unsigned long long b0 = __ballot(s0), b1 = __ballot(s1), b2 = __ballot(s2), b3 = __ballot(s3);
        if (lane == 0) { LAS unsigned* sp = (LAS unsigned*)(lds + OFF_SEL + (wave * 16 + qi) * 32);
            sp[0] = (unsigned)b0; sp[1] = (unsigned)(b0 >> 32); sp[2] = (unsigned)b1; sp[3] = (unsigned)(b1 >> 32);
            sp[4] = (unsigned)b2; sp[5] = (unsigned)(b2 >> 32); sp[6] = (unsigned)b3; sp[7] = (unsigned)(b3 >> 32); }
    }
    __builtin_amdgcn_wave_barrier(); asm volatile("s_waitcnt lgkmcnt(0)" ::: "memory");
    __syncthreads();
    { bf16* pw = BRO + gt * BRW + 768 + kv * 192 + 4 * fq;
#pragma unroll
      for (int g = 0; g < 3; ++g)
#pragma unroll
        for (int dt = 0; dt < 4; ++dt) *(GAS u32x2*)(pw + g * 64 + dt * 16) = part[g][dt]; }
    const int nblk = ((t0 + 127) >> 6) + 1;
    const bf16* Ks = KVS + (size_t)b * SEQ * KVSP + kv * 64; const bf16* Vs = Ks + 128;
    const int curw = (t0 + wave * 16) >> 6;
    const bool cvalid = fr < 12; const int qq = cvalid ? fr / 3 : 0, hh = cvalid ? fr - 3 * qq : 0;
    bf16x8 q4[4][1][2]; int lo4[4][1], hi4[4][1]; AState<1> S4[4];
#pragma unroll
    for (int nb = 0; nb < 4; ++nb) { const int ql = 4 * nb + qq; lo4[nb][0] = 0; hi4[nb][0] = t0 + wave * 16 + ql; state_init<1>(S4[nb]);
        const bf16* qp = Z + ((size_t)b * SEQ + t0 + wave * 16 + ql) * ZP + ZC_QC + (kv * 3 + hh) * 64 + fq * 8; q4[nb][0][0] = *(const GAS bf16x8*)qp; q4[nb][0][1] = *(const GAS bf16x8*)(qp + 32); }
    const float cbias = cvalid ? 0.f : NEG_INF;
    KVRegs r1;
#define SEL_ISSUE(rr, j) { const size_t ro = (size_t)(64 * (j) + srow) * KVSP + sch * 8; kv_issue(rr, Ks + ro, Vs + ro); }
#define SEL_BLOCK(nb, EM, j, Kl, en) { attn_tile<1, EM, true>(S4[nb], Kl, (Kl) + TILE_B, q4[nb], 64 * (j), lo4[nb], hi4[nb], (en) ? cbias : NEG_INF, fr, fq); __builtin_amdgcn_sched_barrier(0); }
    SEL_ISSUE(r, nblk - 2) SEL_ISSUE(r1, nblk - 1)
    kv_commit(lds, 0, r, tid); kv_commit(lds, 1, r1, tid);
    __syncthreads();
    { const LAS unsigned char* Kl = lds + (curw & 1) * 2 * TILE_B;
      SEL_BLOCK(0, true, curw, Kl, true) SEL_BLOCK(1, true, curw, Kl, true) SEL_BLOCK(2, true, curw, Kl, true) SEL_BLOCK(3, true, curw, Kl, true) }
    __syncthreads();
    const int ns = nblk >> 1;
    const LAS unsigned* selw = (const LAS unsigned*)(lds + OFF_SEL + (wave * 16 + qq) * 32);
#define SEL_BITS(j, e0, e1, e2, e3) const int wi_##e0 = (j) >> 5, bi_##e0 = (j) & 31; const bool lt_##e0 = (j) < curw; \
        const bool e0 = ((selw[wi_##e0] >> bi_##e0) & 1u) && lt_##e0, e1 = ((selw[32 + wi_##e0] >> bi_##e0) & 1u) && lt_##e0, e2 = ((selw[64 + wi_##e0] >> bi_##e0) & 1u) && lt_##e0, e3 = ((selw[96 + wi_##e0] >> bi_##e0) & 1u) && lt_##e0;
#define SEL_BLOCKK(nb, j, Kl, en) { f32x4 st_[1][4]; qk_pre(st_, kfr, q4[nb]); attn_rest<1, false, true>(S4[nb], st_, (Kl) + TILE_B, 64 * (j), lo4[nb], hi4[nb], (en) ? cbias : NEG_INF, fr, fq); __builtin_amdgcn_sched_barrier(0); }
#define SEL_TILE(j, slot, e0, e1, e2, e3) { const LAS unsigned char* Kl = lds + (slot) * 2 * TILE_B; \
        if (__any(e0 || e1 || e2 || e3)) { bf16x8 kfr[4][2]; k_frags(kfr, Kl, fr, fq);        \
        if (__any(e0)) SEL_BLOCKK(0, j, Kl, e0) \
        if (__any(e1)) SEL_BLOCKK(1, j, Kl, e1) \
        if (__any(e2)) SEL_BLOCKK(2, j, Kl, e2) \
        if (__any(e3)) SEL_BLOCKK(3, j, Kl, e3) } }
    const int sch8 = ((tid & 7) ^ ((tid >> 4) & 7)) * 8;
    const unsigned ldsb = (unsigned)__builtin_amdgcn_readfirstlane((int)(unsigned)(size_t)lds + wave * 1024);
#define SEL_DMA(slot, j) { const size_t ro = (size_t)(64 * (j) + srow) * KVSP + sch8; \
        const unsigned lk = ldsb + (unsigned)((slot) * 2 * TILE_B), lv = lk + (unsigned)TILE_B; unsigned m0s; \
        asm volatile("s_mov_b32 %0, m0\n\ts_mov_b32 m0, %1\n\ts_nop 0\n\tglobal_load_lds_dwordx4 %3, off\n\ts_mov_b32 m0, %2\n\ts_nop 0\n\tglobal_load_lds_dwordx4 %4, off\n\ts_mov_b32 m0, %0" \
                     : "=&s"(m0s) : "s"(lk), "s"(lv), "v"(Ks + ro), "v"(Vs + ro) : "memory"); }
    const int n3 = (nblk + 2) / 3;
    (void)ns;
    { SEL_DMA(0, 0) if (1 < nblk) SEL_DMA(1, 1) if (2 < nblk) SEL_DMA(2, 2) }
    asm volatile("s_waitcnt vmcnt(0)" ::: "memory");
    __syncthreads();
    for (int s = 0; s < n3; ++s) {
        const int sl = (s & 1) * 3, nsl = 3 - sl, j0 = 3 * s;
        if (s + 1 < n3) { SEL_DMA(nsl, j0 + 3) if (j0 + 4 < nblk) SEL_DMA(nsl + 1, j0 + 4) if (j0 + 5 < nblk) SEL_DMA(nsl + 2, j0 + 5) }
        SEL_BITS(j0, ea0, ea1, ea2, ea3) SEL_BITS(j0 + 1, eb0, eb1, eb2, eb3) SEL_BITS(j0 + 2, ec0, ec1, ec2, ec3)
        SEL_TILE(j0, sl, ea0, ea1, ea2, ea3)
        if (j0 + 1 < nblk) SEL_TILE(j0 + 1, sl + 1, eb0, eb1, eb2, eb3)
        if (j0 + 2 < nblk) SEL_TILE(j0 + 2, sl + 2, ec0, ec1, ec2, ec3)
        asm volatile("s_waitcnt vmcnt(0)" ::: "memory");
        __syncthreads();
    }
#undef SEL_DMA
#undef SEL_TILE
#undef SEL_BLOCKK
#undef SEL_BITS
#undef SEL_BLOCK
#undef SEL_ISSUE
    float lt4[4];
#pragma unroll
    for (int nb = 0; nb < 4; ++nb) lt4[nb] = S4[nb].la[0][0];
    if (cvalid) {
#pragma unroll
        for (int nb = 0; nb < 4; ++nb) { const int ql = 4 * nb + qq; const size_t gq = (size_t)b * SEQ + t0 + wave * 16 + ql;
            const float lt = lt4[nb];
            const float sc = sigmoidf_(bf2f(Z[gq * ZP + ZC_GN + 6 + kv * 3 + hh])) / lt;
            bf16* op = BRO + gq * BRW + 768 + (kv * 3 + hh) * 64 + 4 * fq;
#pragma unroll
            for (int dt = 0; dt < 4; ++dt) { const unsigned long long pv = __hip_atomic_load((const unsigned long long*)(op + dt * 16), __ATOMIC_RELAXED, __HIP_MEMORY_SCOPE_AGENT);
                *(GAS u32x2*)(op + dt * 16) = pack4(S4[nb].o[0][dt] * sc + unpack4((u32x2){(unsigned)pv, (unsigned)(pv >> 32)})); } }
    }
    __syncthreads();
}
}

constexpr int NWAVES = 8;
constexpr size_t MiB = 1u << 20;
constexpr size_t WS_CTL = 0, CTL_ZERO_BYTES = 1 * MiB;
constexpr size_t WS_B1P = 1 * MiB;
constexpr size_t WS_KC = 1 * MiB + 65536, WS_VC = WS_KC + 524288;
constexpr size_t WS_HID = 4 * MiB;
constexpr size_t WS_LSE = 6 * MiB;
constexpr size_t WS_ROUTE = 9 * MiB;
constexpr size_t WS_PB = 11 * MiB;
constexpr size_t WS_WIN = 43 * MiB, WS_WG = 56 * MiB, WS_WB = 64 * MiB, WS_WOUT = 67 * MiB, WS_PG = 69 * MiB, WS_PWW = 71 * MiB, WS_CW1 = 71 * MiB + 524288;
constexpr size_t WS_XB = 74 * MiB;
constexpr size_t WS_BR = 138 * MiB;
constexpr size_t WS_CMP = 234 * MiB;
constexpr size_t WS_Z = 251 * MiB;
constexpr size_t WS_BPROJ = WS_Z, WS_MG = WS_Z + 256 * MiB, WS_Y = WS_Z + 320 * MiB;
constexpr size_t WS_H = WS_Z, WS_FUP = WS_Z + 176 * MiB, WS_FDN = WS_Z + 188 * MiB;
constexpr size_t WS_MDN = 202 * MiB, WS_MUP = 258 * MiB, WS_XP = 370 * MiB, WS_H1 = 502 * MiB;
constexpr size_t WS_XD8 = 347 * MiB;
constexpr size_t WS_XB8 = 320 * MiB;
constexpr size_t WS_KVS = 651 * MiB;
constexpr size_t WS_END = 667 * MiB;
constexpr int XP_ROWS = 65536 + 8 * 256;
constexpr int CHUNK_TILES = 128, CHUNK_LAST = 136, NCHUNK = 2;
static_assert(WS_XP + (size_t)XP_ROWS * D * 2 <= WS_H1 && WS_H1 + (size_t)CHUNK_LAST * 256 * DFE <= WS_KVS && CHUNK_TILES + CHUNK_LAST >= XP_ROWS / 256, "moe map");
static_assert(WS_MDN + (size_t)NE * D * DFE * 2 <= WS_MUP && WS_MUP + (size_t)NE * 2 * DFE * D * 2 <= WS_XP, "moe weights map");
static_assert(WS_Z + (size_t)T * ZP * 2 <= WS_KVS && WS_KVS + (size_t)T * KVSP * 2 <= WS_END && WS_CMP + (size_t)8 * SEQ * 64 * 2 + 4096 <= WS_Z, "z map");
constexpr int CW_TMO = 0, CW_BAR = 4096, CW_CNT = 16384, CW_FILL = 20480;
constexpr int RING_BYTES = 131072, MISC_OFF = RING_BYTES + 320, LDS_BYTES = 151552;
static_assert(att::LDS_END <= RING_BYTES, "attention LDS");

#define RLX_AGENT __ATOMIC_RELAXED, __HIP_MEMORY_SCOPE_AGENT
#define XB_TMO      128
#define XB_XCNT(j)  (256  + 64 * (j))
#define XB_XSUB(j)  (1280 + 64 * (j))
#define XB_XGEN(j)  (2304 + 64 * (j))
#define XB_TOP      3328
#define XB_TOPGEN   3392
#define XCD_BAR_WORDS 3456
#define XB_SPIN_CAP (1u << 22)
__device__ __forceinline__ unsigned xb_ld(unsigned* p)              { return __hip_atomic_load(p, __ATOMIC_RELAXED, __HIP_MEMORY_SCOPE_AGENT); }
__device__ __forceinline__ unsigned xb_add(unsigned* p, unsigned v) { return __hip_atomic_fetch_add(p, v, __ATOMIC_RELAXED, __HIP_MEMORY_SCOPE_AGENT); }
__device__ __forceinline__ unsigned xb_xcc_id() { return (unsigned)__builtin_amdgcn_s_getreg((3 << 11) | 20) & 0xFu; }
#define XB_SPIN(cond, bar) do { unsigned _sp = 0; while (cond) { __builtin_amdgcn_s_sleep(1); \
    if ((++_sp & 255u) == 0u) { if (xb_ld(&(bar)[XB_TMO])) break; if (_sp > XB_SPIN_CAP) { atomicAdd(&(bar)[XB_TMO], 1u); break; } } } } while (0)
struct XcdBarrier { unsigned* bar; unsigned x; volatile LAS unsigned* st; };
__device__ __forceinline__ XcdBarrier xcd_barrier_post(unsigned* bar, volatile LAS unsigned* st) {
    XcdBarrier b; b.bar = bar; b.x = xb_xcc_id(); b.st = st;
    if (threadIdx.x == 0) (void)xb_add(&bar[XB_XCNT(b.x)], 1u);
    return b;
}
__device__ __forceinline__ void xcd_barrier_complete(unsigned* bar, unsigned x, unsigned& nloc, unsigned& nx) {
    const unsigned G = gridDim.x * gridDim.y * gridDim.z;
    unsigned sum, cnt, mine, sp = 0u;
    for (;;) {
        sum = 0u; cnt = 0u; mine = 0u;
#pragma unroll
        for (unsigned j = 0; j < 16; ++j) { const unsigned c = xb_ld(&bar[XB_XCNT(j)]); sum += c; cnt += (c > 0u) ? 1u : 0u; mine = (j == x) ? c : mine; }
        if (sum == G) break;
        __builtin_amdgcn_s_sleep(1);
        if ((++sp & 255u) == 0u) { if (xb_ld(&bar[XB_TMO])) break; if (sp > XB_SPIN_CAP) { atomicAdd(&bar[XB_TMO], 1u); break; } }
    }
    nloc = mine > 0u ? mine : 1u; nx = cnt > 0u ? cnt : 1u;
}
__device__ __forceinline__ void xcd_barrier(const XcdBarrier& b) {
    asm volatile("s_waitcnt vmcnt(0)" ::: "memory");
    __syncthreads();
    if (threadIdx.x == 0) {
        unsigned* bar = b.bar;
        __builtin_amdgcn_s_waitcnt(0);
        unsigned nloc = b.st[0], nx = b.st[1];
        if (nloc == 0u) { xcd_barrier_complete(bar, b.x, nloc, nx); b.st[0] = nloc; b.st[1] = nx; }
        const unsigned old = xb_add(&bar[XB_XSUB(b.x)], 1u);
        const unsigned gen = old / nloc;
        if (old + 1u == (gen + 1u) * nloc) {
            __builtin_amdgcn_fence(__ATOMIC_RELEASE, "agent");
            asm volatile("s_waitcnt vmcnt(0)" ::: "memory");
            const unsigned og = xb_add(&bar[XB_TOP], 1u);
            const unsigned tg = og / nx;
            if (og + 1u == (tg + 1u) * nx) xb_add(&bar[XB_TOPGEN], 1u);
            else XB_SPIN(xb_ld(&bar[XB_TOPGEN]) == tg, bar);
            __builtin_amdgcn_fence(__ATOMIC_ACQUIRE, "agent");
            xb_add(&bar[XB_XGEN(b.x)], 1u);
            asm volatile("s_waitcnt vmcnt(0)" ::: "memory");
        } else {
            XB_SPIN(xb_ld(&bar[XB_XGEN(b.x)]) == gen, bar);
            __builtin_amdgcn_fence(__ATOMIC_ACQUIRE, "agent");
            asm volatile("s_waitcnt vmcnt(0)" ::: "memory");
        }
    }
    __syncthreads();
}

template <class MapF>
__device__ __forceinline__ void conv_job(int gw, int NGW, int lane, LAS float* scr, bf16* WT, int K, int nrows, size_t ldw, const MapF& map) {
    const int nkb = K / 64, nitems = (nrows / 32) * nkb;
    for (int it = gw; it < nitems; it += NGW) {
        const int rb = it / nkb, kb = it % nkb, r0 = rb * 32, k0 = kb * 64;
        const float* src = map(r0 + (lane & 31));
#pragma unroll 8
        for (int i = 0; i < 32; ++i) { const int kk = 2 * i + (lane >> 5); scr[kk * 33 + (lane & 31)] = src ? src[(size_t)(k0 + kk) * ldw] : 0.f; }
        asm volatile("s_waitcnt lgkmcnt(0)" ::: "memory"); __builtin_amdgcn_wave_barrier();
        const int c = lane & 7;
#pragma unroll
        for (int j = 0; j < 4; ++j) { const int n = (lane >> 3) + 8 * j; const LAS float* s = scr + (8 * c) * 33 + n;
            u32x4 o; o.x = cvt_pk_bf16(s[0 * 33], s[1 * 33]); o.y = cvt_pk_bf16(s[2 * 33], s[3 * 33]); o.z = cvt_pk_bf16(s[4 * 33], s[5 * 33]); o.w = cvt_pk_bf16(s[6 * 33], s[7 * 33]);
            *(GAS u32x4*)(WT + (size_t)(r0 + n) * K + k0 + 8 * c) = o; }
        asm volatile("s_waitcnt lgkmcnt(0)" ::: "memory"); __builtin_amdgcn_wave_barrier();
    }
}
template <bool VEC, class MapF>
__device__ __forceinline__ void conv_job2(int gw, int NGW, int lane, LAS unsigned char* scrb, bf16* WT, int K, int nrows, size_t ldw, const MapF& map) {
    const int nkb = K / 64, nitems = (nrows / 64) * nkb;
    const int n4 = (lane & 15) * 4, kq = lane >> 4;
    for (int it = gw; it < nitems; it += NGW) {
        const int rb = it / nkb, kb = it % nkb, r0 = rb * 64, k0 = kb * 64;
        f32x4 v[16];
        if constexpr (VEC) { const float* src = map(r0 + n4);
#pragma unroll
            for (int i = 0; i < 16; ++i) v[i] = src ? *(const GAS f32x4*)(src + (size_t)(k0 + kq * 16 + i) * ldw) : (f32x4){0.f, 0.f, 0.f, 0.f};
        } else { const float* s0 = map(r0 + n4); const float* s1 = map(r0 + n4 + 1); const float* s2 = map(r0 + n4 + 2); const float* s3 = map(r0 + n4 + 3);
#pragma unroll
            for (int i = 0; i < 16; ++i) { const size_t o = (size_t)(k0 + kq * 16 + i) * ldw;
                v[i][0] = s0 ? ((const GAS float*)s0)[o] : 0.f; v[i][1] = s1 ? ((const GAS float*)s1)[o] : 0.f; v[i][2] = s2 ? ((const GAS float*)s2)[o] : 0.f; v[i][3] = s3 ? ((const GAS float*)s3)[o] : 0.f; } }
#pragma unroll
        for (int j = 0; j < 4; ++j)
#pragma unroll
            for (int hf = 0; hf < 2; ++hf) { const int row = n4 + j, c = kq * 2 + hf;
                const f32x4 a = {v[8 * hf + 0][j], v[8 * hf + 1][j], v[8 * hf + 2][j], v[8 * hf + 3][j]}, b = {v[8 * hf + 4][j], v[8 * hf + 5][j], v[8 * hf + 6][j], v[8 * hf + 7][j]};
                *(LAS bf16x8*)(scrb + row * 144 + ((c ^ ((row >> 2) & 7)) * 16)) = pack8(a, b); }
        asm volatile("s_waitcnt lgkmcnt(0)" ::: "memory"); __builtin_amdgcn_wave_barrier();
#pragma unroll
        for (int q = 0; q < 8; ++q) { const int row = q * 8 + (lane >> 3), c = lane & 7;
            const bf16x8 w = *(const LAS bf16x8*)(scrb + row * 144 + ((c ^ ((row >> 2) & 7)) * 16));
            *(GAS bf16x8*)(WT + (size_t)(r0 + row) * K + k0 + c * 8) = w; }
        asm volatile("s_waitcnt lgkmcnt(0)" ::: "memory"); __builtin_amdgcn_wave_barrier();
    }
}
template <class MapF, class ScF>
__device__ __forceinline__ void conv_job8(int gw, int NGW, int lane, LAS unsigned char* scrb, unsigned char* WT, int K, int nrows, size_t ldw, const MapF& map, const ScF& scf) {
    const int nkb = K / 64, nitems = (nrows / 64) * nkb;
    const int n4 = (lane & 15) * 4, kq = lane >> 4;
    for (int it = gw; it < nitems; it += NGW) {
        const int rb = it / nkb, kb = it % nkb, r0 = rb * 64, k0 = kb * 64;
        f32x4 v[16];
        const float* src = map(r0 + n4); const float sc = scf(r0);
#pragma unroll
        for (int i = 0; i < 16; ++i) v[i] = *(const GAS f32x4*)(src + (size_t)(k0 + kq * 16 + i) * ldw) * sc;
#pragma unroll
        for (int j = 0; j < 4; ++j) { const int row = n4 + j;
            const u32x4 w = {cvt4_fp8(v[0][j], v[1][j], v[2][j], v[3][j]), cvt4_fp8(v[4][j], v[5][j], v[6][j], v[7][j]), cvt4_fp8(v[8][j], v[9][j], v[10][j], v[11][j]), cvt4_fp8(v[12][j], v[13][j], v[14][j], v[15][j])};
            *(LAS u32x4*)(scrb + row * 80 + kq * 16) = w; }
        asm volatile("s_waitcnt lgkmcnt(0)" ::: "memory"); __builtin_amdgcn_wave_barrier();
#pragma unroll
        for (int q = 0; q < 4; ++q) { const int row = q * 16 + (lane >> 2), c = lane & 3;
            const u32x4 w = *(const LAS u32x4*)(scrb + row * 80 + c * 16);
            *(GAS u32x4*)(WT + (size_t)(r0 + row) * K + k0 + c * 16) = w; }
        asm volatile("s_waitcnt lgkmcnt(0)" ::: "memory"); __builtin_amdgcn_wave_barrier();
    }
}
__device__ __forceinline__ int zmap_src(int r) {
    if (r < 4992) return r;
    if (r < 5120) return 5504 + (r - 4992);
    if (r < 5248) return 5248 + (r - 5120);
    if (r < 5376) return 5376 + (r - 5248);
    if (r < 5504) return 5632 + (r - 5376);
    if (r < 5888) return 5778 + (r - 5504);
    if (r < 6016) return 6162 + (r - 5888);
    if (r < 6144) return 6290 + (r - 6016);
    if (r < 6162) return 5760 + (r - 6144);
    if (r < 6400) return -1;
    if (r < 6528) return 4992 + (r - 6400);
    return 5120 + (r - 6528);
}

struct Args { const float* in[29]; float* out; unsigned char* ws; int ph_lo, ph_hi; };

__device__ __forceinline__ void ln_store(f32x4 (&v)[4], float* xrow, bf16* brow, const float* g, const float* bb, int lane) {
    float s = 0.f;
#pragma unroll
    for (int j = 0; j < 4; ++j) s += (v[j][0] + v[j][1]) + (v[j][2] + v[j][3]);
    const float mean = wave_sum(s) * (1.f / D); float s2 = 0.f;
#pragma unroll
    for (int j = 0; j < 4; ++j) { v[j] = v[j] - mean; s2 += (v[j][0] * v[j][0] + v[j][1] * v[j][1]) + (v[j][2] * v[j][2] + v[j][3] * v[j][3]); }
    const float rstd = 1.f / sqrtf(wave_sum(s2) * (1.f / D) + LN_EPS);
#pragma unroll
    for (int j = 0; j < 4; ++j) { const f32x4 gv = *(const GAS f32x4*)(g + 256 * j + 4 * lane), bv = *(const GAS f32x4*)(bb + 256 * j + 4 * lane);
        v[j] = v[j] * rstd * gv + bv;
        if (xrow) *(GAS f32x4*)(xrow + 256 * j + 4 * lane) = v[j];
        if (brow) *(GAS u32x2*)(brow + 256 * j + 4 * lane) = pack4(v[j]); }
}

typedef __attribute__((address_space(4))) const unsigned long long kq_t;
__device__ __forceinline__ unsigned long long karg_q(int i) {
    unsigned long long p = (unsigned long long)__builtin_amdgcn_kernarg_segment_ptr(); asm volatile("" : "+s"(p));
    return *(kq_t*)(p + 8ull * i);
}
#define AIN(i) ((const float*)karg_q(i))
#define AOUT ((float*)karg_q(29))
#define LIN(i, stride) (AIN(i) + (size_t)layer * (stride))
#define P_XB   ((bf16*)(ws + WS_XB))
#define P_BR   ((bf16*)(ws + WS_BR))
#define P_Z    ((bf16*)(ws + WS_Z))
#define P_CMP  ((bf16*)(ws + WS_CMP))
#define P_KVS  ((bf16*)(ws + WS_KVS))
#define P_PB   ((bf16*)(ws + WS_PB))
#define P_KC   ((bf16*)(ws + WS_KC))
#define P_VC   ((bf16*)(ws + WS_VC))
#define P_HID  ((bf16*)(ws + WS_HID))
#define P_LSE  ((float*)(ws + WS_LSE))
#define P_B1P  ((float*)(ws + WS_B1P))
#define P_WIN  ((bf16*)(ws + WS_WIN))
#define P_WG   ((bf16*)(ws + WS_WG))
#define P_WB   ((bf16*)(ws + WS_WB))
#define P_WOUT ((bf16*)(ws + WS_WOUT))
#define P_WPG  ((bf16*)(ws + WS_PG))
#define P_WPW  ((bf16*)(ws + WS_PWW))
#define P_WC1  ((bf16*)(ws + WS_CW1))
#define P_BPROJ ((bf16*)(ws + WS_BPROJ))
#define P_MG   ((bf16*)(ws + WS_MG))
#define P_Y    ((bf16*)(ws + WS_Y))
#define P_PLE  ((bf16*)(ws + WS_BR))
#define P_H    ((bf16*)(ws + WS_H))
#define P_WFUP ((bf16*)(ws + WS_FUP))
#define P_WFDN ((bf16*)(ws + WS_FDN))
#define P_WMDN ((bf16*)(ws + WS_MDN))
#define P_WMUP ((bf16*)(ws + WS_MUP))
#define P_XP   ((bf16*)(ws + WS_XP))
#define P_XB8  ((unsigned char*)(ws + WS_XB8))
#define P_XD8  ((unsigned char*)(ws + WS_XD8))
#define P_XM8  ((unsigned char*)AOUT)
#define P_H1   ((bf16*)(ws + WS_H1))
#define P_RE   ((int*)(ws + WS_ROUTE))
#define P_RPOS ((int*)(ws + WS_ROUTE) + 2 * T)
#define P_RW   ((float*)(ws + WS_ROUTE) + 4 * T)
#define P_SLOT ((int*)(ws + WS_ROUTE) + 6 * T)
#define P_ROWW ((float*)(ws + WS_ROUTE) + 8 * T)
#define P_SRC  ((int*)(ws + WS_ROUTE) + 8 * T + 69632)

__device__ __forceinline__ int gw_rot(int gw, int NGW, int n) { while (n >= NGW) n -= NGW; const int g = gw - n; return g < 0 ? g + NGW : g; }
__device__ __forceinline__ void load_seg(gu32* ctl, volatile LAS unsigned* MISC) {
    if (threadIdx.x == 0) { int s = 0;
        for (int e = 0; e < NE; ++e) { MISC[16 + e] = (unsigned)s; const int c = (int)__hip_atomic_load((unsigned*)ctl + CW_CNT + 64 * e, RLX_AGENT); s += (c + 255) & ~255; }
        MISC[16 + NE] = (unsigned)s; }
    __syncthreads();
}

__global__ void __launch_bounds__(NWAVES * 64, 2) mega_fwd(Args args) {
    extern __shared__ __attribute__((aligned(16))) unsigned char lds_raw[];
    LAS unsigned char* lds = (LAS unsigned char*)lds_raw;
    volatile LAS unsigned* MISC = (volatile LAS unsigned*)(lds + MISC_OFF);
    const int G = gridDim.x, bx = blockIdx.x;
    const int NGW = G * NWAVES, NGT = G * NWAVES * 64;
#define PH_IDS int tid = threadIdx.x; asm volatile("" : "+v"(tid)); const int lane = tid & 63, wave = __builtin_amdgcn_readfirstlane(tid >> 6); \
    const int gw = bx * NWAVES + wave, gtid = bx * (NWAVES * 64) + tid; LAS unsigned char* const scr = lds + wave * 16384; (void)lane; (void)gw; (void)gtid; (void)scr;
    unsigned char* const ws = (unsigned char*)karg_q(30);
    gu32* const ctl = (gu32*)(ws + WS_CTL);
    { PH_IDS for (int u = tid; u < (LDS_BYTES - RING_BYTES) / 4; u += NWAVES * 64) ((LAS unsigned*)(lds + RING_BYTES))[u] = 0u; }
    __syncthreads();
    const int lo = (int)(unsigned)karg_q(31), hi = (int)(karg_q(31) >> 32);
    XcdBarrier bar; bar.bar = (unsigned*)ctl + CW_BAR; bar.x = 0; bar.st = nullptr;
    if (hi - lo > 1) bar = xcd_barrier_post((unsigned*)ctl + CW_BAR, MISC + 8);
    int ph = 0;
#define PH_ON (ph >= lo && ph < hi)
#ifndef REP_INPROJ
#define REP_INPROJ 1
#endif
#ifndef REP_BPROJ
#define REP_BPROJ 1
#endif
#ifndef REP_GATES
#define REP_GATES 1
#endif
#ifndef REP_ATT1
#define REP_ATT1 1
#endif
#ifndef REP_ATT2
#define REP_ATT2 1
#endif
#ifndef REP_MOE
#define REP_MOE 1
#endif
#ifndef REP_MID
#define REP_MID 1
#endif
#ifndef REP_PREP
#define REP_PREP 1
#endif
#define PH_END do { if (ph >= lo && ph + 1 < hi) xcd_barrier(bar); ++ph; } while (0)

    for (int layer = 0; layer < 2; ++layer) {
        const bool moe = (layer & 1) != 0;

        if (PH_ON) for (int rep = 0; rep < REP_PREP; ++rep) { PH_IDS
            int gr = gw;
            { const float* w_in = LIN(2, (size_t)D * NIN_SRC);
              conv_job2<false>(gr, NGW, lane, scr, P_WIN, D, NZ, NIN_SRC, [=](int r) -> const float* { const int s = zmap_src(r); return s >= 0 ? w_in + s : nullptr; }); }
            { const float* w_branch = LIN(10, (size_t)4 * 384 * D);
              conv_job2<true>((gr = gw_rot(gr, NGW, 1664)), NGW, lane, scr, P_WB, 384, 4096, D, [=](int r) -> const float* { return w_branch + (size_t)(r >> 10) * 384 * D + (r & 1023); }); }
            { const float* w_mgate = LIN(11, (size_t)4 * D * D);
              conv_job8((gr = gw_rot(gr, NGW, 384)), NGW, lane, scr, (unsigned char*)P_WG, D, 4096, D, [=](int r) -> const float* { const int pn = r >> 8, bj = (r >> 7) & 1, wc = (r >> 5) & 3, fq = (r >> 3) & 3, n = (r >> 2) & 1, i = r & 3;
                return w_mgate + (size_t)(2 * bj + n) * D * D + (64 * pn + 16 * wc + 4 * fq + i); }, [](int) -> float { return F8_SG; }); }
            { const float* w_out = LIN(13, (size_t)D * D);
              conv_job2<true>((gr = gw_rot(gr, NGW, 1024)), NGW, lane, scr, P_WOUT, D, D, D, [=](int r) -> const float* { return w_out + r; }); }
            { const float* ple_gw = LIN(25, (size_t)D * D);
              conv_job2<true>((gr = gw_rot(gr, NGW, 256)), NGW, lane, scr, P_WPG, D, D, D, [=](int r) -> const float* { return ple_gw + r; }); }
            { const float* ple_w = LIN(24, (size_t)PLED * D);
              conv_job2<true>((gr = gw_rot(gr, NGW, 256)), NGW, lane, scr, P_WPW, PLED, D, D, [=](int r) -> const float* { return ple_w + r; }); }
            { const float* cmp_w1 = LIN(5, (size_t)2 * 2048 * 128);
              conv_job2<true>((gr = gw_rot(gr, NGW, 64)), NGW, lane, scr, P_WC1, 2048, 512, 128, [=](int r) -> const float* { const int kv2 = r >> 8, n = r & 255; return n < 128 ? cmp_w1 + (size_t)kv2 * 2048 * 128 + n : nullptr; });
              const float* cmp_pos = LIN(4, 2 * 32 * 64); const float* cmp_b1 = LIN(6, 2 * 128);
              for (int o = (gr = gw_rot(gr, NGW, 256)); o < 256; o += NGW) { const int kv2 = o >> 7, n = o & 127; float s = 0.f;
                for (int k = lane; k < 2048; k += 64) s += cmp_pos[kv2 * 2048 + k] * cmp_w1[((size_t)kv2 * 2048 + k) * 128 + n];
                s = wave_sum(s); if (lane == 0) P_B1P[o] = s + cmp_b1[o]; } }
            if (layer == 0) {
                const float* x = AIN(0); const float* p = AIN(1); bf16* XB = P_XB; bf16* PB = P_PB;
                unsigned char* X8 = P_XM8;
                for (size_t i = (size_t)gtid; i < (size_t)T * D / 8; i += NGT) { const f32x4 a = *(const GAS f32x4*)(x + i * 8), b = *(const GAS f32x4*)(x + i * 8 + 4); *(GAS bf16x8*)(XB + i * 8) = pack8(a, b);
                    const f32x4 a8 = a * F8_SX, b8 = b * F8_SX; *(GAS u32x2*)(X8 + i * 8) = (u32x2){cvt4_fp8(a8[0], a8[1], a8[2], a8[3]), cvt4_fp8(b8[0], b8[1], b8[2], b8[3])}; }
                for (size_t i = (size_t)gtid; i < (size_t)2 * T * PLED / 8; i += NGT) { const f32x4 a = *(const GAS f32x4*)(p + i * 8), b = *(const GAS f32x4*)(p + i * 8 + 4); *(GAS bf16x8*)(PB + i * 8) = pack8(a, b); }
            }
        }
        PH_END;

        if (PH_ON) for (int rep = 0; rep < REP_INPROJ; ++rep) { PH_IDS
            pg8::SchedPlain S; S.init(T / 256, NZ / 256, G, bx); S.A = (const char*)P_XB; S.B = (const char*)P_WIN; S.at = (size_t)256 * D * 2; S.bt = (size_t)256 * D * 2;
            pg8::EpiZ E{P_Z, P_CMP, P_KVS};
            pg8::gemm_phase<pg8::EpiZ, pg8::SchedPlain, true>(lds, D, D, S, E);
        }
        PH_END;

        if (PH_ON) for (int rep = 0; rep < (layer == 0 ? REP_ATT1 : 1); ++rep) { PH_IDS
            const bool dry = rep + 1 < (layer == 0 ? REP_ATT1 : 1); bf16* const DUM = (bf16*)AOUT;
            { pg8::SchedCmp S; S.A = (const char*)P_CMP; S.B = (const char*)P_WC1; S.G = G; S.c = bx;
              pg8::EpiHid E{P_HID, P_B1P};
              pg8::gemm_phase<pg8::EpiHid, pg8::SchedCmp, false>(lds, 2048, 1024, S, E); }
            bf16* const Z = P_Z; bf16* const BR = P_BR;
            unsigned pend = 0; if (!dry && tid == 0) pend = __hip_atomic_fetch_add((unsigned*)ctl + CW_FILL + 128 + 64 * layer, 1u, RLX_AGENT);
            for (int it = 0; ; ++it) {
                int u;
                if (!dry) { if (tid == 0) { MISC[12 + (it & 1)] = pend; pend = __hip_atomic_fetch_add((unsigned*)ctl + CW_FILL + 128 + 64 * layer, 1u, RLX_AGENT); }
                    __syncthreads(); u = (int)MISC[12 + (it & 1)]; }
                else { u = it * G + bx; __syncthreads(); }
                if (u >= 2816) break;
                if (u < 512) {
                    const int b = u >> 8, kv = (u >> 7) & 1, tt = u & 127;
                    att::BandedArgs<3> a; a.Q = Z + ZC_QC + kv * 192; a.K = Z + ZC_KW + kv * 64; a.V = Z + ZC_VW + kv * 64; a.pitch = ZP; a.tok0 = b * SEQ; a.dil = 1; a.p0 = tt * 128; a.W = 511;
                    a.qcol_nb = 64; a.qrow_nb = 0; a.rpw = 16; a.O = (dry ? DUM : BR) + 768 + kv * 192; a.opitch = BRW; a.ocol_nb = 64; a.lse = nullptr; a.lse_stride = 0; a.sink = nullptr;
                    att::banded_unit<3>(lds, a);
                } else if (u < 2816) {
                    const int d = u - 512, g = d / 768, rr = d % 768, h = rr % 6, r2 = rr / 6, b = r2 >> 6, r3 = r2 & 63;
                    const int sh = 2 * g, dil = 1 << sh, cls = r3 & (dil - 1), pblk = r3 >> sh;
                    att::BandedArgs<2> a; a.Q = Z + ZC_QA + (g * 6 + h) * 64; a.K = Z + ZC_KA + (g * 6 + h) * 64; a.V = Z + ZC_VA + (g * 6 + h) * 64; a.pitch = ZP; a.tok0 = b * SEQ + cls; a.dil = dil;
                    a.p0 = pblk * 256; a.W = 128; a.qcol_nb = 0; a.qrow_nb = 16; a.rpw = 32; a.O = dry ? DUM + h * 64 : Z + ZC_QA + (g * 6 + h) * 64; a.opitch = dry ? BRW : ZP; a.ocol_nb = 0;
                    a.lse = P_LSE + g * 6 + h; a.lse_stride = 18; a.sink = nullptr;
                    att::banded_unit<2, true>(lds, a);
                }
            }
        }
        PH_END;

        if (PH_ON) for (int rep = 0; rep < REP_MID; ++rep) { PH_IDS
            const float* cmp_w2 = LIN(7, 2 * 128 * 64); const float* cmp_b2 = LIN(8, 2 * 64); const bf16* HID = P_HID;
            for (int i = tid; i < 2 * 128 * 64 / 4; i += NWAVES * 64) *(LAS f32x4*)(lds + i * 16) = *(const GAS f32x4*)(cmp_w2 + i * 4);
            __syncthreads();
            for (int row = gw; row < 2 * 4096; row += NGW) {
                const int kv2 = row >> 12, r = row & 4095;
                float s = 0.f;
                if ((r & 1023) != 1023) { s = cmp_b2[kv2 * 64 + lane]; const bf16* hp = HID + (size_t)row * 128; const LAS float* w2 = (const LAS float*)lds + kv2 * 128 * 64 + lane;
                    u32x4 hw[16];
#pragma unroll
                    for (int h8 = 0; h8 < 16; ++h8) hw[h8] = *(const GAS u32x4*)(hp + h8 * 8);
#pragma unroll
                    for (int h8 = 0; h8 < 16; ++h8) { const f32x4 a = unpack4((u32x2){hw[h8].x, hw[h8].y}), b = unpack4((u32x2){hw[h8].z, hw[h8].w});
#pragma unroll
                        for (int i = 0; i < 4; ++i) { s += a[i] * w2[(h8 * 8 + i) * 64]; s += b[i] * w2[(h8 * 8 + 4 + i) * 64]; } } }
                (kv2 ? P_VC : P_KC)[(size_t)r * 64 + lane] = (bf16)(cvt_pk_bf16(s, 0.f) & 0xffffu);
            }
            __syncthreads();
            const float* LSE = P_LSE; const bf16* Z = P_Z; bf16* BR = P_BR;
            for (int idx0 = gtid; idx0 < T * 48; idx0 += 4 * NGT) {
                float l0[4], l1[4], l2[4]; u32x4 a0[4], a1[4], a2[4];
#pragma unroll
                for (int q = 0; q < 4; ++q) { int idx = idx0 + q * NGT; idx = idx < T * 48 ? idx : idx0; const int tok = idx / 48, rem = idx % 48, h = rem >> 3, d8 = rem & 7;
                    l0[q] = LSE[(size_t)tok * 18 + h]; l1[q] = LSE[(size_t)tok * 18 + 6 + h]; l2[q] = LSE[(size_t)tok * 18 + 12 + h];
                    const bf16* zr = Z + (size_t)tok * ZP + h * 64 + d8 * 8;
                    a0[q] = *(const GAS u32x4*)zr; a1[q] = *(const GAS u32x4*)(zr + 384); a2[q] = *(const GAS u32x4*)(zr + 768); }
#pragma unroll
                for (int q = 0; q < 4; ++q) { const int idx = idx0 + q * NGT; if (idx < T * 48) { const int tok = idx / 48, rem = idx % 48, h = rem >> 3, d8 = rem & 7;
                    const float mx = fmaxf(l0[q], fmaxf(l1[q], l2[q])); float e0 = ex2((l0[q] - mx) * LOG2E), e1 = ex2((l1[q] - mx) * LOG2E), e2 = ex2((l2[q] - mx) * LOG2E); const float inv = 1.f / (e0 + e1 + e2); e0 *= inv; e1 *= inv; e2 *= inv;
                    const f32x4 r0 = unpack4((u32x2){a0[q].x, a0[q].y}) * e0 + unpack4((u32x2){a1[q].x, a1[q].y}) * e1 + unpack4((u32x2){a2[q].x, a2[q].y}) * e2;
                    const f32x4 r1 = unpack4((u32x2){a0[q].z, a0[q].w}) * e0 + unpack4((u32x2){a1[q].z, a1[q].w}) * e1 + unpack4((u32x2){a2[q].z, a2[q].w}) * e2;
                    *(GAS bf16x8*)(BR + (size_t)tok * BRW + h * 64 + d8 * 8) = pack8(r0, r1); } }
            }
        }
        PH_END;

        if (PH_ON) for (int rep = 0; rep < (layer == 0 ? REP_ATT2 : 1); ++rep) { PH_IDS
            const bool dry = rep + 1 < (layer == 0 ? REP_ATT2 : 1);
            for (int u = bx; u < 512; u += G) {
                const int uu = u & 255, bk = uu & 3, tt = (u < 256) ? (uu >> 2) : 127 - (uu >> 2), b = bk >> 1, kv = bk & 1;
                att::nsa_unit(lds, P_Z, P_KVS, P_KC + (size_t)(b * 2 + kv) * 1024 * 64, P_VC + (size_t)(b * 2 + kv) * 1024 * 64, P_BR, dry ? (bf16*)AOUT : P_BR, b, kv, tt * 128);
            }
            if (!dry) {
                bf16* const Z = P_Z; bf16* const BR = P_BR; bf16* const DUM = BR;
                for (int fi = 0; ; ++fi) { if (tid == 0) MISC[12 + (fi & 1)] = __hip_atomic_fetch_add((unsigned*)ctl + CW_FILL + 64 * layer, 1u, RLX_AGENT);
                    __syncthreads(); const int f = (int)MISC[12 + (fi & 1)];
                    if (f >= 768) break;
                    const int u = f < 256 ? 3328 + f : 2816 + (f - 256);
                if (u < 3328) {
                    const int w = u - 2816, b = w >> 8, kv = (w >> 7) & 1, tt = w & 127;
                    att::BandedArgs<3> a; a.Q = Z + ZC_QD + kv * 192; a.K = Z + ZC_KD + kv * 64; a.V = Z + ZC_VD + kv * 64; a.pitch = ZP; a.tok0 = b * SEQ; a.dil = 1; a.p0 = tt * 128; a.W = 127;
                    a.qcol_nb = 64; a.qrow_nb = 0; a.rpw = 16; a.O = (dry ? DUM : BR) + 1152 + kv * 192; a.opitch = BRW; a.ocol_nb = 64; a.lse = nullptr; a.lse_stride = 0; a.sink = LIN(9, 6) + kv * 3;
                    att::banded_unit<3>(lds, a);
                } else {
                    const int cu = u - 3328; const float* conv_w = LIN(3, 3 * 384);
                    for (int it = tid; it < 128 * 48; it += NWAVES * 64) {
                        const int tl = it / 48, c8 = it % 48, tok = cu * 128 + tl, ts = tok & (SEQ - 1);
                        const bf16* zr = Z + (size_t)tok * ZP;
                        const u32x4 gbw = *(const GAS u32x4*)(zr + ZC_GB + c8 * 8);
                        f32x4 y0 = {0.f, 0.f, 0.f, 0.f}, y1 = {0.f, 0.f, 0.f, 0.f};
#pragma unroll
                        for (int k = 0; k < 3; ++k) { const int dt = 2 - k;
                            if (ts >= dt) { const bf16* zz = zr - (size_t)dt * ZP; const u32x4 gcw = *(const GAS u32x4*)(zz + ZC_GC + c8 * 8), hbw = *(const GAS u32x4*)(zz + ZC_HB + c8 * 8);
                                const f32x4 w0 = *(const GAS f32x4*)(conv_w + k * 384 + c8 * 8), w1 = *(const GAS f32x4*)(conv_w + k * 384 + c8 * 8 + 4);
                                y0 += w0 * unpack4((u32x2){gcw.x, gcw.y}) * unpack4((u32x2){hbw.x, hbw.y}); y1 += w1 * unpack4((u32x2){gcw.z, gcw.w}) * unpack4((u32x2){hbw.z, hbw.w}); } }
                        *(GAS bf16x8*)((dry ? DUM : BR) + (size_t)tok * BRW + 384 + c8 * 8) = pack8(y0 * unpack4((u32x2){gbw.x, gbw.y}), y1 * unpack4((u32x2){gbw.z, gbw.w}));
                    }
                }
                }
            }
        }
        PH_END;

        if (PH_ON) for (int rep = 0; rep < REP_BPROJ; ++rep) { PH_IDS
            pg8::SchedBproj S; S.init(T / 256, 16, G, bx); S.A = (const char*)P_BR; S.B = (const char*)P_WB; S.at = (size_t)256 * BRW * 2; S.bt = (size_t)256 * 384 * 2;
            pg8::EpiBf16 E{P_BPROJ, 4096};
            pg8::gemm_phase<pg8::EpiBf16, pg8::SchedBproj, true>(lds, 384, BRW, S, E);
        }
        PH_END;

        if (PH_ON) for (int rep = 0; rep < REP_GATES; ++rep) { PH_IDS
            pg8::SchedPlain S; S.init(T / 256, 16, G, bx); S.A = (const char*)P_XM8; S.B = (const char*)P_WG; S.at = (size_t)256 * D; S.bt = (size_t)256 * D;
            pg8::EpiGateSum E{P_BPROJ, LIN(12, 4 * D), P_MG, 1.f / (F8_SX * F8_SG)};
            pg8::gemm_phase<pg8::EpiGateSum, pg8::SchedPlain, true, false, true>(lds, D / 2, D / 2, S, E);
        }
        PH_END;

        if (PH_ON) { PH_IDS
            { pg8::SchedPlain S; S.init(T / 256, 4, G, bx); S.A = (const char*)P_MG; S.B = (const char*)P_WOUT; S.at = (size_t)256 * D * 2; S.bt = (size_t)256 * D * 2;
              pg8::EpiBf16 E{P_Y, D};
              pg8::gemm_phase<pg8::EpiBf16, pg8::SchedPlain, true>(lds, D, D, S, E); }
            if (!moe) {
              pg8::SchedPlain S; S.init(T / 256, 4, G, bx); S.A = (const char*)(P_PB + (size_t)layer * T * PLED); S.B = (const char*)P_WPW; S.at = (size_t)256 * PLED * 2; S.bt = (size_t)256 * PLED * 2;
              pg8::EpiBf16 E{P_PLE, D};
              pg8::gemm_phase<pg8::EpiBf16, pg8::SchedPlain, true>(lds, PLED, PLED, S, E); }
        }
        PH_END;

        if (PH_ON) { PH_IDS
            if (!moe) {
                const float* fg = AIN(16); const float* fu = AIN(17); const float* fd = AIN(18);
                conv_job8(gw, NGW, lane, scr, (unsigned char*)P_WFUP, D, 2 * DFF, DFF, [=](int r) -> const float* { const int pn = r >> 8, half = (r >> 7) & 1, f = 128 * pn + (r & 127); return (half ? fu : fg) + f; }, [](int r) -> float { return ((r >> 7) & 1) ? F8_SU : F8_SG; });
                conv_job8(gw, NGW, lane, scr, (unsigned char*)P_WFDN, DFF, D, D, [=](int r) -> const float* { return fd + r; }, [](int) -> float { return F8_SD; });
            } else {
                const float* mg_ = AIN(21); const float* mu_ = AIN(22); const float* md_ = AIN(23);
                conv_job8(gw, NGW, lane, scr, (unsigned char*)P_WMUP, D, NE * 2 * DFE, DFE, [=](int r) -> const float* { const int e = r / (2 * DFE), rr = r % (2 * DFE), pn = rr >> 8, half = (rr >> 7) & 1, f = 128 * pn + (rr & 127);
                    return (half ? mu_ : mg_) + (size_t)e * D * DFE + f; }, [](int r) -> float { return ((r >> 7) & 1) ? F8_SU : F8_SG; });
                conv_job8(gw, NGW, lane, scr, (unsigned char*)P_WMDN, DFE, NE * D, D, [=](int r) -> const float* { return md_ + (size_t)(r >> 10) * DFE * D + (r & 1023); }, [](int) -> float { return F8_SD; });
            }
            __syncthreads();
            if (moe) { const float* wr_ = AIN(19); for (int i = tid; i < D * NE; i += NWAVES * 64) ((LAS float*)lds)[i] = wr_[i];
                int* src = P_SRC;
#pragma nounroll
                for (int i = gtid; i < XP_ROWS; i += NGT) { asm volatile("" : "+v"(i)); src[i] = 0; } }
            __syncthreads();
            const float* lg_ = LIN(14, D); const float* lb_ = LIN(15, D); bf16* const XB = P_XB;
            const bf16* const Yb = P_Y;
            int pm = -1, pi1 = 0, pi2 = 0, pp1 = 0, pp2 = 0; float pw1 = 0.f, pw2 = 0.f;
            for (int m = gw; m < T; m += NGW) {
                f32x4 v[4];
#pragma unroll
                for (int j = 0; j < 4; ++j) v[j] = unpack4(*(const GAS u32x2*)(XB + (size_t)m * D + 256 * j + 4 * lane)) * ALPHA + unpack4(*(const GAS u32x2*)(Yb + (size_t)m * D + 256 * j + 4 * lane));
                ln_store(v, nullptr, XB + (size_t)m * D, lg_, lb_, lane);
                if (!moe) { unsigned char* x8 = P_XD8 + (size_t)m * D;
#pragma unroll
                    for (int j = 0; j < 4; ++j) *(GAS unsigned*)(x8 + 256 * j + 4 * lane) = cvt4_fp8(v[j][0] * F8_SX, v[j][1] * F8_SX, v[j][2] * F8_SX, v[j][3] * F8_SX); }
                if (moe) {
                    float l0 = 0.f, l1 = 0.f, l2 = 0.f, l3 = 0.f, l4 = 0.f, l5 = 0.f, l6 = 0.f, l7 = 0.f;
#pragma unroll
                    for (int j = 0; j < 4; ++j)
#pragma unroll
                        for (int i = 0; i < 4; ++i) { const LAS float* wp = (const LAS float*)lds + (256 * j + 4 * lane + i) * NE; const f32x4 w0 = *(const LAS f32x4*)wp, w1 = *(const LAS f32x4*)(wp + 4);
                            l0 += v[j][i] * w0[0]; l1 += v[j][i] * w0[1]; l2 += v[j][i] * w0[2]; l3 += v[j][i] * w0[3];
                            l4 += v[j][i] * w1[0]; l5 += v[j][i] * w1[1]; l6 += v[j][i] * w1[2]; l7 += v[j][i] * w1[3]; }
                    const float* br_ = AIN(20);
                    l0 = wave_sum(l0) + br_[0]; l1 = wave_sum(l1) + br_[1]; l2 = wave_sum(l2) + br_[2]; l3 = wave_sum(l3) + br_[3];
                    l4 = wave_sum(l4) + br_[4]; l5 = wave_sum(l5) + br_[5]; l6 = wave_sum(l6) + br_[6]; l7 = wave_sum(l7) + br_[7];
                    int i1 = 0; float v1 = l0;
                    if (l1 > v1) { v1 = l1; i1 = 1; } if (l2 > v1) { v1 = l2; i1 = 2; } if (l3 > v1) { v1 = l3; i1 = 3; } if (l4 > v1) { v1 = l4; i1 = 4; }
                    if (l5 > v1) { v1 = l5; i1 = 5; } if (l6 > v1) { v1 = l6; i1 = 6; } if (l7 > v1) { v1 = l7; i1 = 7; }
                    int i2 = -1; float v2 = -__builtin_inff();
                    if (i1 != 0 && l0 > v2) { v2 = l0; i2 = 0; } if (i1 != 1 && l1 > v2) { v2 = l1; i2 = 1; } if (i1 != 2 && l2 > v2) { v2 = l2; i2 = 2; } if (i1 != 3 && l3 > v2) { v2 = l3; i2 = 3; }
                    if (i1 != 4 && l4 > v2) { v2 = l4; i2 = 4; } if (i1 != 5 && l5 > v2) { v2 = l5; i2 = 5; } if (i1 != 6 && l6 > v2) { v2 = l6; i2 = 6; } if (i1 != 7 && l7 > v2) { v2 = l7; i2 = 7; }
                    const float w1 = 1.f / (1.f + __expf(v2 - v1)), w2 = 1.f - w1;
                    if (lane == 0) {
                        int* re = P_RE; int* rp = P_RPOS; float* rw = P_RW;
                        if (pm >= 0) { re[2 * pm] = pi1; re[2 * pm + 1] = pi2; rp[2 * pm] = pp1; rp[2 * pm + 1] = pp2; rw[2 * pm] = pw1; rw[2 * pm + 1] = pw2; }
                        pp1 = (int)__hip_atomic_fetch_add((unsigned*)ctl + CW_CNT + 64 * i1, 1u, RLX_AGENT); pp2 = (int)__hip_atomic_fetch_add((unsigned*)ctl + CW_CNT + 64 * i2, 1u, RLX_AGENT);
                    }
                    pm = m; pi1 = i1; pi2 = i2; pw1 = w1; pw2 = w2;
                }
            }
            if (moe && lane == 0 && pm >= 0) { int* re = P_RE; int* rp = P_RPOS; float* rw = P_RW; re[2 * pm] = pi1; re[2 * pm + 1] = pi2; rp[2 * pm] = pp1; rp[2 * pm + 1] = pp2; rw[2 * pm] = pw1; rw[2 * pm + 1] = pw2; }
        }
        PH_END;

        if (!moe) {
            if (PH_ON) { PH_IDS
                { pg8::SchedPlain S; S.init(T / 256, 22, G, bx); S.A = (const char*)P_XD8; S.B = (const char*)P_WFUP; S.at = (size_t)256 * D; S.bt = (size_t)256 * D;
                  pg8::EpiUp8 E{(unsigned char*)P_H, DFF, 0};
                  pg8::gemm_phase<pg8::EpiUp8, pg8::SchedPlain, true, false, true>(lds, D / 2, D / 2, S, E); }
                { pg8::SchedPlain S2; S2.init(T / 256, 4, G, bx); S2.A = (const char*)P_XB; S2.B = (const char*)P_WPG; S2.at = (size_t)256 * D * 2; S2.bt = (size_t)256 * D * 2;
                  pg8::EpiUp E2{nullptr, 0, 0, 0, LIN(26, D), P_PLE};
                  pg8::gemm_phase<pg8::EpiUp, pg8::SchedPlain, true>(lds, D, D, S2, E2); }
            }
            PH_END;
            if (PH_ON) { PH_IDS
                pg8::SchedPlain S; S.init(T / 256, 4, G, bx); S.A = (const char*)P_H; S.B = (const char*)P_WFDN; S.at = (size_t)256 * DFF; S.bt = (size_t)256 * DFF;
                pg8::EpiDown E{P_XB, P_PLE, 1.f / (F8_SH * F8_SD)};
                pg8::gemm_phase<pg8::EpiDown, pg8::SchedPlain, true, false, true>(lds, DFF / 2, DFF / 2, S, E);
            }
            PH_END;
        } else {
            const LAS int* segl = (const LAS int*)(lds + MISC_OFF + 64);
            if (PH_ON) { PH_IDS
                load_seg(ctl, MISC);
                const int* re = P_RE; const int* rp = P_RPOS; const float* rw = P_RW; int* slot = P_SLOT; float* roww = P_ROWW; int* src = P_SRC;
#pragma nounroll
                for (int it = gtid; it < 2 * T; it += NGT) { asm volatile("" : "+v"(it)); const int row = segl[re[it]] + rp[it]; slot[it] = row; roww[row] = rw[it]; src[row] = it >> 1; }
                { const bf16* XB = P_XB; unsigned char* X8 = P_XB8;
#pragma nounroll
                  for (int i = gtid; i < T * D / 8; i += NGT) { asm volatile("" : "+v"(i)); const u32x4 w = *(const GAS u32x4*)(XB + (size_t)i * 8);
                    const f32x4 a = unpack4((u32x2){w.x, w.y}) * F8_SX, b = unpack4((u32x2){w.z, w.w}) * F8_SX;
                    *(GAS u32x2*)(X8 + (size_t)i * 8) = (u32x2){cvt4_fp8(a[0], a[1], a[2], a[3]), cvt4_fp8(b[0], b[1], b[2], b[3])}; } }
            }
            PH_END;
            for (int ch = 0; ch < NCHUNK; ++ch) {
                const int tile0 = ch * CHUNK_TILES, cap = ch == NCHUNK - 1 ? CHUNK_LAST : CHUNK_TILES;
                if (PH_ON) for (int rep = 0; rep < REP_MOE; ++rep) { PH_IDS
                    load_seg(ctl, MISC);
                    int ntile = (__builtin_amdgcn_readfirstlane(segl[NE]) >> 8) - tile0; ntile = ntile < 0 ? 0 : (ntile > cap ? cap : ntile);
                    pg8::SchedMoeG S; S.A = (const char*)P_XB8; S.B = (const char*)P_WMUP; S.at = (size_t)256 * D; S.bt_tile = (size_t)256 * D; S.bt_exp = (size_t)2 * DFE * D;
                    S.G = G; S.c = bx; S.nN = 28; S.tile0 = tile0; S.ntile = ntile; S.seg = segl; S.lidx = (const LAS int*)(lds + MISC_OFF + 2048);
                    { const int* src = P_SRC; int vals[8];
#pragma unroll
                      for (int j = 0; j < 8; ++j) { pg8::Unit uu; const bool ok = S.next((tid >> 8) + 2 * j, uu); vals[j] = ok ? src[uu.pm * 256 + (tid & 255)] : 0; }
#pragma unroll
                      for (int j = 0; j < 8; ++j) ((LAS int*)(lds + MISC_OFF + 2048))[((tid >> 8) + 2 * j) * 256 + (tid & 255)] = vals[j];
                      __syncthreads(); }
                    pg8::EpiUp8 E{(unsigned char*)P_H1, DFE, tile0 * 256};
                    pg8::gemm_phase<pg8::EpiUp8, pg8::SchedMoeG, true, true, true>(lds, D / 2, D / 2, S, E);
                }
                PH_END;
                if (PH_ON) for (int rep = 0; rep < REP_MOE; ++rep) { PH_IDS
                    load_seg(ctl, MISC);
                    int ntile = (__builtin_amdgcn_readfirstlane(segl[NE]) >> 8) - tile0; ntile = ntile < 0 ? 0 : (ntile > cap ? cap : ntile);
                    pg8::SchedMoe S; S.A = (const char*)P_H1; S.B = (const char*)P_WMDN; S.at = (size_t)256 * DFE; S.bt_tile = (size_t)256 * DFE; S.bt_exp = (size_t)D * DFE;
                    S.G = G; S.c = bx; S.nN = 4; S.tile0 = tile0; S.ntile = ntile; S.seg = segl;
                    pg8::EpiMoeDown E{P_XP, P_ROWW, 1.f / (F8_SH * F8_SD)};
                    pg8::gemm_phase<pg8::EpiMoeDown, pg8::SchedMoe, true, false, true>(lds, DFE / 2, DFE / 2, S, E);
                    if (ch == NCHUNK - 1) {
                        const int rem = (ntile * 4) % G; const int skip = (G >= 64 && rem <= 32) ? rem : (G >= 64 ? 32 : 0);
                        if (bx >= skip) {
                            { pg8::SchedPlain S1; S1.init(T / 256, 4, G - skip, bx - skip); S1.A = (const char*)(P_PB + (size_t)layer * T * PLED); S1.B = (const char*)P_WPW; S1.at = (size_t)256 * PLED * 2; S1.bt = (size_t)256 * PLED * 2;
                              pg8::EpiBf16 E1{P_PLE, D};
                              pg8::gemm_phase<pg8::EpiBf16, pg8::SchedPlain, true>(lds, PLED, PLED, S1, E1); }
                            pg8::SchedPlain S2; S2.init(T / 256, 4, G - skip, bx - skip); S2.A = (const char*)P_XB; S2.B = (const char*)P_WPG; S2.at = (size_t)256 * D * 2; S2.bt = (size_t)256 * D * 2;
                            pg8::EpiUp E2{nullptr, 0, 0, 0, LIN(26, D), P_PLE};
                            pg8::gemm_phase<pg8::EpiUp, pg8::SchedPlain, true>(lds, D, D, S2, E2); }
                    }
                }
                PH_END;
            }
        }

        if (PH_ON) { PH_IDS
            const float* lg_ = LIN(27, D); const float* lb_ = LIN(28, D); float* const xres = AOUT; bf16* const XB = P_XB; const bf16* XP = P_XP; const bf16* PL = P_PLE; const int* slot = P_SLOT;
            for (int m = gw; m < T; m += NGW) {
                float* xr = xres + (size_t)m * D; bf16* xb = XB + (size_t)m * D; f32x4 v[4];
#pragma unroll
                for (int j = 0; j < 4; ++j) v[j] = unpack4(*(const GAS u32x2*)(xb + 256 * j + 4 * lane));
                if (moe) { const int s0 = slot[2 * m], s1 = slot[2 * m + 1];
#pragma unroll
                    for (int j = 0; j < 4; ++j) { const int c = 256 * j + 4 * lane;
                        v[j] = v[j] * ALPHA + unpack4(*(const GAS u32x2*)(XP + (size_t)s0 * D + c)) + unpack4(*(const GAS u32x2*)(XP + (size_t)s1 * D + c)) + unpack4(*(const GAS u32x2*)(PL + (size_t)m * D + c)); } }
                ln_store(v, layer == 0 ? nullptr : xr, layer == 0 ? xb : nullptr, lg_, lb_, lane);
                if (layer == 0) { unsigned char* x8 = P_XM8 + (size_t)m * D;
#pragma unroll
                    for (int j = 0; j < 4; ++j) *(GAS unsigned*)(x8 + 256 * j + 4 * lane) = cvt4_fp8(v[j][0] * F8_SX, v[j][1] * F8_SX, v[j][2] * F8_SX, v[j][3] * F8_SX); }
            }
        }
        PH_END;
    }
#undef PH_ON
#undef PH_END
}

#ifndef MK_PER_PHASE
#define MK_PER_PHASE 0
#endif
constexpr int N_PHASES = 12 + 15;
extern "C" void kernel_launch(void* const* d_in, const int* in_sizes, int n_in, void* d_out, int out_size, void* d_ws, size_t ws_size, hipStream_t stream) {
    static int grid = 0;
    if (grid == 0) {
        if (n_in != 29 || out_size != T * D || ws_size < WS_END) { fprintf(stderr, "kernel_launch: unexpected problem (n_in %d, out %d, ws %zu < %zu); nothing launched\n", n_in, out_size, ws_size, (size_t)WS_END); grid = -1; return; }
        int dev = 0, cus = 0, per_cu = 0;
        if (hipGetDevice(&dev) != hipSuccess || hipDeviceGetAttribute(&cus, hipDeviceAttributeMultiprocessorCount, dev) != hipSuccess) { grid = -1; return; }
        if (hipFuncSetAttribute((const void*)mega_fwd, hipFuncAttributeMaxDynamicSharedMemorySize, LDS_BYTES) != hipSuccess) { fprintf(stderr, "kernel_launch: hipFuncSetAttribute failed\n"); grid = -1; return; }
        if (hipOccupancyMaxActiveBlocksPerMultiprocessor(&per_cu, (const void*)mega_fwd, NWAVES * 64, LDS_BYTES) != hipSuccess || per_cu < 1) { fprintf(stderr, "kernel_launch: occupancy query says %d blocks per CU\n", per_cu); (void)hipGetLastError(); grid = -1; return; }
        grid = cus;
    }
    if (grid < 0) return;
    if (hipMemsetAsync((char*)d_ws + WS_CTL, 0, CTL_ZERO_BYTES, stream) != hipSuccess) return;
    Args a{};
    for (int i = 0; i < 29; ++i) a.in[i] = (const float*)d_in[i];
    a.out = (float*)d_out; a.ws = (unsigned char*)d_ws;
#if MK_PER_PHASE
    for (int p = 0; p < N_PHASES; ++p) { a.ph_lo = p; a.ph_hi = p + 1; hipLaunchKernelGGL(mega_fwd, dim3(grid), dim3(NWAVES * 64), LDS_BYTES, stream, a); }
#else
    a.ph_lo = 0; a.ph_hi = 1 << 20;
    hipLaunchKernelGGL(mega_fwd, dim3(grid), dim3(NWAVES * 64), LDS_BYTES, stream, a);
#endif
}
```
